# Optimizing an MI355X kernel written in HIP

```python
import math
import jax, jax.numpy as jnp
from jax import lax
import numpy as np

D_MODEL = 1024
BATCH = 4
SEQ = 4096
DEPTH = 2

CHUNK = 64
RET_HEADS = 4
RET_DK = 64
RET_DV = 128
RET_QK_WIDTH = RET_HEADS * RET_DK
RET_WIDTH = RET_HEADS * RET_DV
ROPE_BASE = 10000.0
CONV_CH = D_MODEL // 2
CONV_WIDTH = 31
L0_IN = 2 * RET_QK_WIDTH + 2 * RET_WIDTH + 2 * CONV_CH
L0_OUT_IN = RET_WIDTH + CONV_CH
SB_HEADS = 8
SB_HEAD_DIM = D_MODEL // SB_HEADS
SB_BLOCK = 128
N_EXPERTS = 32
TOP_K = 4
D_FF = D_MODEL
SWIGLU_LIMIT = 7.0
SWIGLU_ALPHA = 1.702
EXPERT_BLOCK = 128
LN_EPS = 1e-5
DEEPNORM_ALPHA = (2 * DEPTH) ** 0.25
DEEPNORM_BETA = (8 * DEPTH) ** -0.25

kernel_name = 'hybrid_retention_conformer_stickbreaking_moe_deepnorm'


def layer_norm(x, g, b):
    xf = x.astype(jnp.float32)
    mu = jnp.mean(xf, axis=-1, keepdims=True)
    var = jnp.mean(jnp.square(xf - mu), axis=-1, keepdims=True)
    y = (xf - mu) * lax.rsqrt(var + LN_EPS)
    return (y * g.astype(jnp.float32) + b.astype(jnp.float32)).astype(x.dtype)


def rotary(x, positions):
    half = x.shape[-1] // 2
    inv = ROPE_BASE ** (-jnp.arange(half, dtype=jnp.float32) / half)
    ang = positions.astype(jnp.float32)[:, None] * inv[None, :]
    cos = jnp.cos(ang)[None, :, None, :].astype(x.dtype)
    sin = jnp.sin(ang)[None, :, None, :].astype(x.dtype)
    x1, x2 = x[..., :half], x[..., half:]
    return jnp.concatenate([x1 * cos - x2 * sin, x2 * cos + x1 * sin], axis=-1)


def retention_chunkwise(q, k, v):
    B, S, H, dk = q.shape
    dv = v.shape[-1]
    nc = S // CHUNK
    to_chunks = lambda t: t.reshape(B, nc, CHUNK, H, t.shape[-1]).transpose(0, 3, 1, 2, 4)
    qc, kc, vc = to_chunks(q), to_chunks(k), to_chunks(v)
    log_g = jnp.log(1.0 - 2.0 ** (-5.0 - jnp.arange(H, dtype=jnp.float32)))
    n = jnp.arange(CHUNK, dtype=jnp.float32)
    dt = q.dtype
    intra_decay = jnp.exp(jnp.abs(n[:, None] - n[None, :])[None] * log_g[:, None, None]).astype(dt)
    xi = jnp.exp((n[None, :] + 1.0) * log_g[:, None]).astype(dt)
    zeta = jnp.exp((CHUNK - 1.0 - n[None, :]) * log_g[:, None]).astype(dt)
    g_chunk = jnp.exp(CHUNK * log_g)
    scores = jnp.einsum('bhcnd,bhcmd->bhcnm', qc, kc) * intra_decay[None, :, None]
    intra = jnp.einsum('bhcnm,bhcme->bhcne', scores, vc)
    kv = jnp.einsum('bhcmd,bhcme->cbhde', kc * zeta[None, :, None, :, None], vc)
    g_state = g_chunk[None, :, None, None].astype(kv.dtype)

    def step(state, kv_c):
        return g_state * state + kv_c, state

    _, r_prev = lax.scan(step, jnp.zeros((B, H, dk, dv), kv.dtype), kv)
    inter = jnp.einsum('bhcnd,cbhde->bhcne', qc * xi[None, :, None, :, None], r_prev)
    out = intra + inter
    return out.transpose(0, 2, 3, 1, 4).reshape(B, S, H, dv)


def depthwise_causal_conv(u, w, b):
    y = lax.conv_general_dilated(u, w[:, None, :], window_strides=(1,),
                                 padding=[(CONV_WIDTH - 1, 0)],
                                 dimension_numbers=('NWC', 'WIO', 'NWC'),
                                 feature_group_count=u.shape[-1])
    return y + b


def retention_conv_mixer(x, w_in, ret_gn_g, conv_w, conv_b, conv_ln_g, conv_ln_b, w_out):
    B, S, _ = x.shape
    h = x @ w_in
    q, k, v, gate, glu_a, glu_b = jnp.split(
        h, [RET_QK_WIDTH, 2 * RET_QK_WIDTH, 2 * RET_QK_WIDTH + RET_WIDTH,
            2 * RET_QK_WIDTH + 2 * RET_WIDTH, 2 * RET_QK_WIDTH + 2 * RET_WIDTH + CONV_CH], axis=-1)
    pos = jnp.arange(S)
    q = rotary(q.reshape(B, S, RET_HEADS, RET_DK), pos)
    k = rotary(k.reshape(B, S, RET_HEADS, RET_DK), pos) * (RET_DK ** -0.5)
    v = v.reshape(B, S, RET_HEADS, RET_DV)
    r = retention_chunkwise(q, k, v).astype(jnp.float32)
    mu = jnp.mean(r, axis=-1, keepdims=True)
    var = jnp.mean(jnp.square(r - mu), axis=-1, keepdims=True)
    r = ((r - mu) * lax.rsqrt(var + LN_EPS)).reshape(B, S, RET_WIDTH) * ret_gn_g.astype(jnp.float32)
    ret_out = jax.nn.silu(gate) * r.astype(x.dtype)
    u = glu_a * jax.nn.sigmoid(glu_b)
    c = depthwise_causal_conv(u, conv_w, conv_b)
    c = jax.nn.silu(layer_norm(c, conv_ln_g, conv_ln_b))
    return jnp.concatenate([ret_out, c], axis=-1) @ w_out


def stick_breaking_attention(q, k, v):
    S = q.shape[2]
    scale = q.shape[-1] ** -0.5
    outs = []
    for i in range(S // SB_BLOCK):
        start = i * SB_BLOCK
        end = start + SB_BLOCK
        qb, kb, vb = q[:, :, start:end], k[:, :, :end], v[:, :, :end]
        z = jnp.einsum('bhtd,bhsd->bhts', qb, kb, preferred_element_type=jnp.float32) * scale
        t_idx = start + jnp.arange(SB_BLOCK)
        s_idx = jnp.arange(end)
        mask = s_idx[None, :] < t_idx[:, None]
        log_beta = jax.nn.log_sigmoid(z)
        log_one_minus = jnp.where(mask, jax.nn.log_sigmoid(-z), 0.0)
        between = lax.cumsum(log_one_minus, axis=3, reverse=True) - log_one_minus
        a = jnp.where(mask, jnp.exp(log_beta + between), 0.0)
        outs.append(jnp.einsum('bhts,bhsd->bhtd', a.astype(vb.dtype), vb))
    return jnp.concatenate(outs, axis=2)


def stick_breaking_mixer(x, w_in, w_out):
    B, S, _ = x.shape
    q, k, v = jnp.split(x @ w_in, 3, axis=-1)
    heads = lambda t: t.reshape(B, S, SB_HEADS, SB_HEAD_DIM).transpose(0, 2, 1, 3)
    o = stick_breaking_attention(heads(q), heads(k), heads(v))
    return o.transpose(0, 2, 1, 3).reshape(B, S, D_MODEL) @ w_out


def clamped_swiglu(h):
    h_glu = jnp.minimum(h[..., ::2], SWIGLU_LIMIT)
    h_lin = jnp.clip(h[..., 1::2], -SWIGLU_LIMIT, SWIGLU_LIMIT)
    return h_glu * jax.nn.sigmoid(SWIGLU_ALPHA * h_glu) * (h_lin + 1.0)


def moe(x, router_w, router_b, w_up, b_up, w_down, b_down):
    B, S, D = x.shape
    N = B * S
    NK = N * TOP_K
    xf = x.reshape(N, D)
    logits = jnp.dot(xf, router_w, preferred_element_type=jnp.float32) + router_b.astype(jnp.float32)
    top_vals, top_idx = lax.top_k(logits, TOP_K)
    gates = jax.nn.softmax(top_vals, axis=-1)
    flat_e = top_idx.reshape(NK)
    flat_tok = jnp.repeat(jnp.arange(N, dtype=jnp.int32), TOP_K)
    flat_g = gates.reshape(NK)
    order = jnp.argsort(flat_e)
    sorted_e = flat_e[order]
    counts = jnp.bincount(flat_e, length=N_EXPERTS)
    padded = (counts + EXPERT_BLOCK - 1) // EXPERT_BLOCK * EXPERT_BLOCK
    starts = jnp.cumsum(counts) - counts
    padded_ends = jnp.cumsum(padded)
    padded_starts = padded_ends - padded
    dest = padded_starts[sorted_e] + jnp.arange(NK, dtype=jnp.int32) - starts[sorted_e]
    n_blocks = -(-(NK + N_EXPERTS * (EXPERT_BLOCK - 1)) // EXPERT_BLOCK)
    P = n_blocks * EXPERT_BLOCK
    buf_tok = jnp.zeros((P,), jnp.int32).at[dest].set(flat_tok[order])
    buf_gate = jnp.zeros((P,), jnp.float32).at[dest].set(flat_g[order])
    block_e = jnp.minimum(
        jnp.searchsorted(padded_ends, jnp.arange(n_blocks, dtype=jnp.int32) * EXPERT_BLOCK, side='right'),
        N_EXPERTS - 1)
    xin = xf[buf_tok].reshape(n_blocks, EXPERT_BLOCK, D)

    def expert_block(args):
        xb, e = args
        h = xb @ w_up[e] + b_up[e]
        return clamped_swiglu(h) @ w_down[e] + b_down[e]

    y = lax.map(expert_block, (xin, block_e)).reshape(P, D)
    out = jnp.zeros((N, D), y.dtype).at[buf_tok].add(y * buf_gate[:, None].astype(y.dtype))
    return out.reshape(B, S, D)


def _normal(k, shape, scale):
    return scale * jax.random.normal(k, shape, jnp.float32)


def setup_inputs(seed: int = 0) -> dict:
    key = jax.random.key(seed)
    ks = iter(jax.random.split(key, 64))
    D = D_MODEL
    gain = lambda n: 1.0 + _normal(next(ks), (n,), 0.02)
    bias = lambda n: _normal(next(ks), (n,), 0.02)
    p = {}
    p['x'] = _normal(next(ks), (BATCH, SEQ, D), 1.0)
    p['l0_w_in'] = _normal(next(ks), (D, L0_IN), D ** -0.5)
    p['l0_ret_gn_g'] = gain(RET_WIDTH)
    p['l0_conv_w'] = _normal(next(ks), (CONV_WIDTH, CONV_CH), CONV_WIDTH ** -0.5)
    p['l0_conv_b'] = bias(CONV_CH)
    p['l0_conv_ln_g'] = gain(CONV_CH)
    p['l0_conv_ln_b'] = bias(CONV_CH)
    p['l0_w_out'] = _normal(next(ks), (L0_OUT_IN, D), DEEPNORM_BETA * L0_OUT_IN ** -0.5)
    p['l0_ln1_g'] = gain(D)
    p['l0_ln1_b'] = bias(D)
    p['l0_router_w'] = _normal(next(ks), (D, N_EXPERTS), D ** -0.5)
    p['l0_router_b'] = _normal(next(ks), (N_EXPERTS,), 0.01)
    p['l0_w_up'] = _normal(next(ks), (N_EXPERTS, D, 2 * D_FF), D ** -0.5)
    p['l0_b_up'] = _normal(next(ks), (N_EXPERTS, 2 * D_FF), 0.02)
    p['l0_w_down'] = _normal(next(ks), (N_EXPERTS, D_FF, D), DEEPNORM_BETA * D_FF ** -0.5)
    p['l0_b_down'] = _normal(next(ks), (N_EXPERTS, D), 0.02)
    p['l0_ln2_g'] = gain(D)
    p['l0_ln2_b'] = bias(D)
    p['l1_w_in'] = _normal(next(ks), (D, 3 * D), D ** -0.5)
    p['l1_w_out'] = _normal(next(ks), (D, D), DEEPNORM_BETA * D ** -0.5)
    p['l1_ln1_g'] = gain(D)
    p['l1_ln1_b'] = bias(D)
    p['l1_router_w'] = _normal(next(ks), (D, N_EXPERTS), D ** -0.5)
    p['l1_router_b'] = _normal(next(ks), (N_EXPERTS,), 0.01)
    p['l1_w_up'] = _normal(next(ks), (N_EXPERTS, D, 2 * D_FF), D ** -0.5)
    p['l1_b_up'] = _normal(next(ks), (N_EXPERTS, 2 * D_FF), 0.02)
    p['l1_w_down'] = _normal(next(ks), (N_EXPERTS, D_FF, D), DEEPNORM_BETA * D_FF ** -0.5)
    p['l1_b_down'] = _normal(next(ks), (N_EXPERTS, D), 0.02)
    p['l1_ln2_g'] = gain(D)
    p['l1_ln2_b'] = bias(D)
    return p


def reference(x,
              l0_w_in, l0_ret_gn_g, l0_conv_w, l0_conv_b, l0_conv_ln_g, l0_conv_ln_b, l0_w_out,
              l0_ln1_g, l0_ln1_b,
              l0_router_w, l0_router_b, l0_w_up, l0_b_up, l0_w_down, l0_b_down,
              l0_ln2_g, l0_ln2_b,
              l1_w_in, l1_w_out, l1_ln1_g, l1_ln1_b,
              l1_router_w, l1_router_b, l1_w_up, l1_b_up, l1_w_down, l1_b_down,
              l1_ln2_g, l1_ln2_b):
    mixers = [(l0_w_in, l0_ret_gn_g, l0_conv_w, l0_conv_b, l0_conv_ln_g, l0_conv_ln_b, l0_w_out),
              (l1_w_in, l1_w_out)]
    norms1 = [(l0_ln1_g, l0_ln1_b), (l1_ln1_g, l1_ln1_b)]
    moes = [(l0_router_w, l0_router_b, l0_w_up, l0_b_up, l0_w_down, l0_b_down),
            (l1_router_w, l1_router_b, l1_w_up, l1_b_up, l1_w_down, l1_b_down)]
    norms2 = [(l0_ln2_g, l0_ln2_b), (l1_ln2_g, l1_ln2_b)]
    for layer in range(DEPTH):
        if layer % 2 == 0:
            m = retention_conv_mixer(x, *mixers[layer])
        else:
            m = stick_breaking_mixer(x, *mixers[layer])
        x = layer_norm(DEEPNORM_ALPHA * x + m, *norms1[layer])
        x = layer_norm(DEEPNORM_ALPHA * x + moe(x, *moes[layer]), *norms2[layer])
    return x
```

```cpp
#include <hip/hip_runtime.h>
#include <cstdint>
#include <cstdio>

typedef unsigned short bf16;
#define LAS __attribute__((address_space(3)))
#define GAS __attribute__((address_space(1)))
typedef short bf16x8 __attribute__((ext_vector_type(8)));
typedef float f32x4 __attribute__((ext_vector_type(4)));
typedef float f32x2 __attribute__((ext_vector_type(2)));
typedef float f32x16 __attribute__((ext_vector_type(16)));
typedef unsigned u32x4 __attribute__((ext_vector_type(4)));
typedef unsigned u32x2 __attribute__((ext_vector_type(2)));
typedef int v4i __attribute__((ext_vector_type(4)));
typedef int v8i __attribute__((ext_vector_type(8)));

__device__ __forceinline__ float bf2f(bf16 v) { return __uint_as_float(((unsigned)v) << 16); }
__device__ __forceinline__ unsigned f2bf(float f) { unsigned u = __float_as_uint(f); return (u + 0x7fffu + ((u >> 16) & 1u)) >> 16; }
__device__ __forceinline__ unsigned pk2(float lo, float hi) { return f2bf(lo) | (f2bf(hi) << 16); }
typedef __bf16 bf16x2_t __attribute__((ext_vector_type(2)));
__device__ __forceinline__ unsigned cvt_pk_bf16(float lo, float hi) { const f32x2 v = {lo, hi}; const bf16x2_t b = __builtin_convertvector(v, bf16x2_t); return __builtin_bit_cast(unsigned, b); }
__device__ __forceinline__ float sigmoidf_(float x) { return __builtin_amdgcn_rcpf(1.f + __builtin_amdgcn_exp2f(-1.4426950408889634f * x)); }
template <int CTRL> __device__ __forceinline__ float dpp_mov(float v) { return __builtin_bit_cast(float, __builtin_amdgcn_update_dpp(0, __builtin_bit_cast(int, v), CTRL, 0xF, 0xF, true)); }
__device__ __forceinline__ float row16_sum(float v) { v += dpp_mov<0xB1>(v); v += dpp_mov<0x4E>(v); v += dpp_mov<0x141>(v); v += dpp_mov<0x140>(v); return v; }
__device__ __forceinline__ float lane_bcast(float v, int l) { return __builtin_bit_cast(float, __builtin_amdgcn_readlane(__builtin_bit_cast(int, v), l)); }
__device__ __forceinline__ float wave_sum(float v) { v = row16_sum(v); return (lane_bcast(v, 0) + lane_bcast(v, 16)) + (lane_bcast(v, 32) + lane_bcast(v, 48)); }
__device__ __forceinline__ float half32_sum(float v) { v = row16_sum(v); return v + __shfl_xor(v, 16); }

__device__ __forceinline__ unsigned pk4_fp8(float a, float b, float c, float d) {
    a = __builtin_amdgcn_fmed3f(a, -448.f, 448.f); b = __builtin_amdgcn_fmed3f(b, -448.f, 448.f); c = __builtin_amdgcn_fmed3f(c, -448.f, 448.f); d = __builtin_amdgcn_fmed3f(d, -448.f, 448.f);
    int w = 0; w = __builtin_amdgcn_cvt_pk_fp8_f32(a, b, w, false); w = __builtin_amdgcn_cvt_pk_fp8_f32(c, d, w, true); return (unsigned)w; }
__device__ __forceinline__ unsigned pk4_fp8_inrange(float a, float b, float c, float d) {
    int w = 0; w = __builtin_amdgcn_cvt_pk_fp8_f32(a, b, w, false); w = __builtin_amdgcn_cvt_pk_fp8_f32(c, d, w, true); return (unsigned)w; }
__device__ __forceinline__ f32x4 swiglu4(const f32x4 g, const f32x4 l, const float s) {
    f32x4 a, e, r, b;
#pragma unroll
    for (int j = 0; j < 4; ++j) { a[j] = __builtin_amdgcn_fmed3f(g[j], -3.0e38f, 7.f); b[j] = __builtin_amdgcn_fmed3f(l[j], -7.f, 7.f); }
    const f32x4 x = a * (-1.702f * 1.4426950408889634f);
#pragma unroll
    for (int j = 0; j < 4; ++j) e[j] = __builtin_amdgcn_exp2f(x[j]);
    const f32x4 d = e + 1.f;
#pragma unroll
    for (int j = 0; j < 4; ++j) r[j] = __builtin_amdgcn_rcpf(d[j]);
    const f32x4 t = b * s + s;
    return (a * r) * t;
}
#ifndef MOE_FP8_L0
#define MOE_FP8_L0 1
#endif
#ifndef MOE_FP8_L1
#define MOE_FP8_L1 1
#endif
constexpr bool MOE_FP8[2] = {MOE_FP8_L0 != 0, MOE_FP8_L1 != 0};
#ifndef YSLOT_FP8
#define YSLOT_FP8 1
#endif
constexpr bool YS8 = YSLOT_FP8 != 0; constexpr int SH_Y = 4;
constexpr int SH_WUP = 6, SH_WDN = 6, SH_ACT = 2;
constexpr int SCL_UP = 0x01010101 * (127 - SH_WUP / 2), SCL_DN = 0x01010101 * (127 - (SH_WDN + SH_ACT) / 2);
static_assert(SH_WUP % 2 == 0 && (SH_WDN + SH_ACT) % 2 == 0, "even total shifts");
constexpr int SH_WOUT = 6, SH_MIX = 4; constexpr int SCL_OUT = 0x01010101 * (127 - (SH_WOUT + SH_MIX) / 2);
static_assert((SH_WOUT + SH_MIX) % 2 == 0, "even total shift");
__device__ __forceinline__ unsigned char fp8_1(float a) { a = __builtin_amdgcn_fmed3f(a, -448.f, 448.f); return (unsigned char)(__builtin_amdgcn_cvt_pk_fp8_f32(a, a, 0, false) & 0xff); }
constexpr int D = 1024, BATCH = 4, SEQ = 4096, M = BATCH * SEQ;
constexpr int L0N = 2560, NE = 32, FF = 1024, CAP = 16384;
constexpr float LN_EPS = 1e-5f;
constexpr float ALPHA = 1.4142135623730951f;
constexpr float QSCALE1 = 0.08838834764831845f * 1.4426950408889634f;
constexpr float LN2F = 0.6931471805599453f;
constexpr float SB_EXIT = 7.174648e-43f;

constexpr size_t MiB = 1ull << 20;
constexpr size_t WS_CTL = 0;
constexpr size_t WS_WIN0 = 1 * MiB, WS_WOUT0 = 6 * MiB, WS_WIN1 = 8 * MiB, WS_WOUT1 = 14 * MiB;
constexpr size_t WS_WUP0 = 16 * MiB, WS_WUP1 = 144 * MiB, WS_WDN0 = 272 * MiB, WS_WDN1 = 336 * MiB;
constexpr size_t WS_ROPE = 400 * MiB;
constexpr size_t WS_RWT = 401 * MiB;
constexpr size_t WS_X1F8 = 402 * MiB;
constexpr size_t WS_X1 = 402 * MiB, WS_X1B = 466 * MiB, WS_X2 = 498 * MiB, WS_X2B = 562 * MiB, WS_YPRE = 594 * MiB;
constexpr size_t WS_ROWTOK = 658 * MiB, WS_ROWGATE = 660 * MiB;
constexpr size_t WS_S = 664 * MiB;
constexpr size_t WS_Q0 = WS_S, WS_K0 = WS_S + 8 * MiB, WS_V0 = WS_S + 16 * MiB, WS_SG = WS_S + 32 * MiB, WS_U = WS_S + 48 * MiB, WS_MIX = WS_S + 64 * MiB;
constexpr size_t WS_XBF = WS_S + 96 * MiB;
constexpr size_t WS_QK1 = WS_S, WS_VT1 = WS_S + 64 * MiB, WS_AO = WS_S + 96 * MiB;
constexpr size_t WS_ACT = WS_S;
constexpr size_t WS_YSLOT = 808 * MiB;
constexpr size_t WS_KV = 808 * MiB;
constexpr size_t WS_RT = 840 * MiB;
constexpr size_t WS_HBUF = 808 * MiB;
constexpr size_t WS_END = 1024 * MiB;
constexpr int CW_CNT = 1024, CW_BAR = 8192, CW_RDY = 131072;

namespace pg8 {
constexpr int BM = 256, BK = 64, HALF = 128, HTB = HALF * BK * 2, STAGE_BYTES = 8 * HTB, NXCD = 8, WGM = 8;
__host__ __device__ __forceinline__ int lds_byte(int r, int c) { const int st = (r >> 4) * 2 + (c >> 5), rr = r & 15, cc = c & 31, ob = rr * 64 + cc * 2; return st * 1024 + (ob ^ (((ob >> 9) & 1) << 5)); }
__host__ __device__ __forceinline__ void stage_rc(int b, int& R, int& C) { const int st = b / 1024, sb = b % 1024, swz = sb ^ (((sb >> 9) & 1) << 5); R = (st >> 1) * 16 + swz / 64; C = (st & 1) * 32 + (swz % 64) / 2; }
__host__ __device__ __forceinline__ int perm32(int rho) { const int n = rho >> 4, i = rho & 15; return 8 * (i >> 2) + 4 * n + (i & 3); }

struct Unit { int pm, pn, e; };
struct Gemm { const void* A; const void* Bt; int M, N, K; size_t estride; int scl; unsigned* rdy; };

struct StaticOrder {
    int nM, nN, nwg, G, c; const LAS int* t2e;
    __device__ void init(int nM_, int nN_, int G_, int c_, const LAS int* t2e_) { nM = nM_; nN = nN_; nwg = nM * nN; G = G_; c = c_; t2e = t2e_; }
    __device__ int count() const { return (nwg - c + G - 1) / G; }
    __device__ int ord(int i) const { return (int)((long)i * G + c); }
    __device__ bool next(int i, Unit& u) const {
        const long L = (long)i * G + c; if (L >= nwg) return false;
        int wgid = (int)L; { const int q = nwg / NXCD, r = nwg % NXCD, xcd = wgid % NXCD, off = wgid / NXCD; wgid = (xcd < r ? xcd * (q + 1) : r * (q + 1) + (xcd - r) * q) + off; }
        const int nig = WGM * nN, gid = wgid / nig, fm = gid * WGM, gsz = (nM - fm) < WGM ? (nM - fm) : WGM;
        u.pm = fm + ((wgid % nig) % gsz); u.pn = (wgid % nig) / gsz; u.e = t2e ? t2e[u.pm] : 0; return true;
    }
};

struct XcdOrder {
    int nN, T0, ntx, k, per, nloc; const LAS int* t2e;
    __device__ void init(int nM, int nN_, int G_, int c_, int prevN, const LAS int* t2e_) { nN = nN_; t2e = t2e_; per = G_ / NXCD;
        const int x = c_ % NXCD, q = nM / NXCD, r = nM % NXCD; ntx = q + (x < r ? 1 : 0); T0 = x * q + (x < r ? x : r); nloc = ntx * nN;
        k = (c_ / NXCD - (ntx * prevN) % per + per) % per; }
    __device__ int count() const { return nloc > k ? (nloc - k + per - 1) / per : 0; }
    __device__ int ord(int i) const { return T0 * nN + i * per + k; }
    __device__ bool next(int i, Unit& u) const { const int j = i * per + k; if (j >= nloc) return false;
        const int nig = WGM * nN, fm = (j / nig) * WGM, gsz = (ntx - fm) < WGM ? (ntx - fm) : WGM, w = j % nig;
        u.pm = T0 + fm + w % gsz; u.pn = w / gsz; u.e = t2e[u.pm]; return true; }
};
__device__ __forceinline__ unsigned flow_peek(const unsigned* w) { return (unsigned)__builtin_amdgcn_readfirstlane((int)__hip_atomic_load(w, __ATOMIC_RELAXED, __HIP_MEMORY_SCOPE_AGENT)); }
__device__ __forceinline__ void flow_wait(const unsigned* w, unsigned need) { while (flow_peek(w) < need) __builtin_amdgcn_s_sleep(4); }
__device__ __forceinline__ void flow_wait_wg(const unsigned* w, unsigned need, int wave) { if (wave == 0) { while (flow_peek(w) < need) __builtin_amdgcn_s_sleep(8); } __builtin_amdgcn_s_barrier(); }

__device__ __forceinline__ void mfma_f8(f32x4& acc, const v8i a, const v8i b, const int scl) {
    asm volatile("s_nop 1\n\tv_mfma_scale_f32_16x16x128_f8f6f4 %0, %1, %2, %0, %3, %3 op_sel_hi:[0,0,0]" : "+v"(acc) : "v"(a), "v"(b), "v"(scl));
}
template <class E, class = void> struct has_ldsbias { static constexpr bool v = false; };
template <class E> struct has_ldsbias<E, decltype((void)E::LDSBIAS)> { static constexpr bool v = E::LDSBIAS; };
template <class E, class = void> struct has_accbias { static constexpr bool v = false; };
template <class E> struct has_accbias<E, decltype((void)E::ACCBIAS)> { static constexpr bool v = E::ACCBIAS; };
struct NoRide { __device__ __forceinline__ void begin(int, int, int) {} __device__ __forceinline__ void end(int) {} };
template <class Epi, bool GATHER, bool ALIGN_EPI, bool FP8 = false, class Ride = NoRide, class Ord = StaticOrder, int FLOW = 0, int FLOW_NEED = 0>
__device__ __forceinline__ void gemm_phase(LAS unsigned char* lds, const Gemm g, const Ord& S, const Epi& E, const LAS int* rowtab, const int wave_id, Ride ride = Ride()) {
    int lane_ = (int)__builtin_amdgcn_mbcnt_hi(~0u, __builtin_amdgcn_mbcnt_lo(~0u, 0u)); asm volatile("" : "+v"(lane_));
    const int lane = lane_, wid = wave_id, tid = wid * 64 + lane, wr = wid >> 2, wc = wid & 3, fr = lane & 15, fq = lane >> 4;
    const int K = g.K, rowb = K * (FP8 ? 1 : 2), nt = rowb / 128;
    const size_t kstep = 128;
    const size_t hstep = (size_t)HALF * rowb;
    const size_t tstep = 2 * hstep;
    const int scl_w = g.scl; (void)scl_w;
    unsigned voffB[2], vc[2][2], vn[2][2];
#pragma unroll
    for (int i = 0; i < 2; ++i) { int R, C; stage_rc(tid * 16 + i * 8192, R, C); const int Rb = Epi::PERM ? ((R & ~31) + perm32(R & 31)) : R;
        voffB[i] = (unsigned)(Rb * rowb + C * 2);
        vc[0][i] = (unsigned)(R * rowb + C * 2); vc[1][i] = vc[0][i] + (unsigned)hstep; vn[0][i] = vc[0][i]; vn[1][i] = vc[1][i]; }
    const unsigned ldsw = (unsigned)wid * 1024u;
    const int aoff = lds_byte(wr * 64 + fr, fq * 8), boff = lds_byte(wc * 32 + fr, fq * 8);
#define PG8_SA(b, h) (((b) * 2 + (h)) * HTB)
#define PG8_SB(b, h) ((4 + (b) * 2 + (h)) * HTB)
#define PG8_STAGE(bufoff, gbase, voff) do { _Pragma("unroll") for (int _i = 0; _i < 2; ++_i) \
        __builtin_amdgcn_global_load_lds((const unsigned*)((const char*)(gbase) + (voff)[_i]), (LAS unsigned*)(lds + (bufoff) + ldsw + _i * 8192), 16, 0, 0); } while (0)
#define PG8_LDA(dst, b, h) do { _Pragma("unroll") for (int m = 0; m < 4; ++m) _Pragma("unroll") for (int k = 0; k < 2; ++k) dst[m][k] = *(const LAS bf16x8*)(lds + PG8_SA(b, h) + aoff + m * 2048 + k * 1024); } while (0)
#define PG8_LDB(dst, b, h) do { _Pragma("unroll") for (int n = 0; n < 2; ++n) _Pragma("unroll") for (int k = 0; k < 2; ++k) dst[n][k] = *(const LAS bf16x8*)(lds + PG8_SB(b, h) + boff + n * 2048 + k * 1024); } while (0)
#define PG8_CAT(x0, x1) __builtin_shufflevector(__builtin_bit_cast(v4i, x0), __builtin_bit_cast(v4i, x1), 0, 1, 2, 3, 4, 5, 6, 7)
#define PG8_MMA(ai, bj, At, Bt) do { __builtin_amdgcn_s_setprio(1); if constexpr (FP8) { _Pragma("unroll") for (int m = 0; m < 4; ++m) _Pragma("unroll") for (int n = 0; n < 2; ++n) \
        mfma_f8(acc[ai][bj][m][n], PG8_CAT(Bt[n][0], Bt[n][1]), PG8_CAT(At[m][0], At[m][1]), scl_w); } else { \
        _Pragma("unroll") for (int m = 0; m < 4; ++m) _Pragma("unroll") for (int n = 0; n < 2; ++n) _Pragma("unroll") for (int k = 0; k < 2; ++k) \
        acc[ai][bj][m][n] = __builtin_amdgcn_mfma_f32_16x16x32_bf16(Bt[n][k], At[m][k], acc[ai][bj][m][n], 0, 0, 0); } __builtin_amdgcn_s_setprio(0); } while (0)
#define PG8_WAIT_V(n) asm volatile("s_waitcnt vmcnt(" #n ")" ::: "memory")
#define PG8_WAIT_L(n) asm volatile("s_waitcnt lgkmcnt(" #n ")" ::: "memory")
#define PG8_BAR __builtin_amdgcn_s_barrier()
#define PG8_SCHED __builtin_amdgcn_sched_barrier(0)
#define PG8_ROWOFF(dst, slot) do { if constexpr (GATHER) { _Pragma("unroll") for (int _i = 0; _i < 2; ++_i) { int _R, _C; stage_rc(tid * 16 + _i * 8192, _R, _C); _Pragma("unroll") for (int _h = 0; _h < 2; ++_h) \
        dst[_h][_i] = (unsigned)rowtab[(slot) * 256 + _h * 128 + _R] * (unsigned)rowb + (unsigned)(_C * 2); } } } while (0)
    Unit cur, nxt; int ui = 0;
    if (!S.next(0, cur)) return;
    int pub_pm = -1; (void)pub_pm;
    if constexpr (FLOW == 2) { flow_wait(g.rdy + cur.pm, FLOW_NEED); if (S.next(1, nxt)) flow_wait(g.rdy + nxt.pm, FLOW_NEED); }
    if constexpr (has_ldsbias<Epi>::v) { if (wid < 4) __builtin_amdgcn_global_load_lds((const unsigned*)(E.bias(cur) + wid * 64 + lane), (LAS unsigned*)(E.bl + wid * 64), 4, 0, 0); }
    f32x4 acc[2][2][4][2];
    if constexpr (has_accbias<Epi>::v) { asm volatile("s_waitcnt vmcnt(0)" ::: "memory"); __builtin_amdgcn_s_barrier(); E.init(acc, 0, wc, fq); }
    else {
#pragma unroll
    for (int a = 0; a < 2; ++a)
#pragma unroll
        for (int b = 0; b < 2; ++b)
#pragma unroll
            for (int m = 0; m < 4; ++m)
#pragma unroll
                for (int n = 0; n < 2; ++n) acc[a][b][m][n] = (f32x4){0.f, 0.f, 0.f, 0.f}; }
    bf16x8 At[4][2], B0[2][2], B1[2][2];
    PG8_ROWOFF(vc, 0);
    const char* cA = GATHER ? (const char*)g.A : (const char*)g.A + (size_t)cur.pm * tstep;
    const char* cB = (const char*)g.Bt + (size_t)cur.e * g.estride + (size_t)cur.pn * tstep;
    PG8_STAGE(PG8_SB(0, 0), cB, voffB); PG8_STAGE(PG8_SB(0, 1), cB + hstep, voffB); PG8_STAGE(PG8_SA(0, 0), cA, vc[0]); PG8_STAGE(PG8_SA(0, 1), cA, vc[1]);
    if (wr == 1) PG8_BAR;
    PG8_WAIT_V(2); PG8_BAR;
    PG8_STAGE(PG8_SB(1, 0), cB + kstep, voffB); PG8_STAGE(PG8_SA(1, 0), cA + kstep, vc[0]); PG8_STAGE(PG8_SB(1, 1), cB + hstep + kstep, voffB);
    PG8_WAIT_V(6); PG8_BAR;
    for (;;) {
        const bool has_next = S.next(ui + 1, nxt);
        const char* nA = GATHER ? cA : (has_next ? (const char*)g.A + (size_t)nxt.pm * tstep : cA);
        const char* nB = has_next ? (const char*)g.Bt + (size_t)nxt.e * g.estride + (size_t)nxt.pn * tstep : cB;
        if constexpr (has_ldsbias<Epi>::v) { if (has_next && wid < 4) __builtin_amdgcn_global_load_lds((const unsigned*)(E.bias(nxt) + wid * 64 + lane), (LAS unsigned*)(E.bl + ((ui + 1) % 3) * 256 + wid * 64), 4, 0, 0); }
        if constexpr (GATHER) { if (has_next) { PG8_ROWOFF(vn, ui + 1); } else {
#pragma unroll
            for (int h = 0; h < 2; ++h)
#pragma unroll
                for (int i = 0; i < 2; ++i) vn[h][i] = vc[h][i]; } }
#pragma nounroll
        for (int t = 0; t < nt; t += 2) {
            const bool last = (t == nt - 2);
            const char* a1 = cA + (size_t)(t + 1) * kstep;
            const char* a2 = last ? nA : cA + (size_t)(t + 2) * kstep; const char* b2 = last ? nB : cB + (size_t)(t + 2) * kstep;
            const char* a3 = a2 + kstep; const char* b3 = b2 + kstep;
            unsigned w0[2], w1[2];
#pragma unroll
            for (int i = 0; i < 2; ++i) { w0[i] = (GATHER && last) ? vn[0][i] : vc[0][i]; w1[i] = (GATHER && last) ? vn[1][i] : vc[1][i]; }
            PG8_LDB(B0, 0, 0); PG8_LDB(B1, 0, 1); PG8_SCHED; PG8_LDA(At, 0, 0); PG8_STAGE(PG8_SA(1, 1), a1, vc[1]);
            PG8_WAIT_V(8); PG8_WAIT_L(0); PG8_BAR; PG8_MMA(0, 0, At, B0); PG8_MMA(0, 1, At, B1); PG8_BAR; PG8_SCHED;
            PG8_LDA(At, 0, 1); PG8_STAGE(PG8_SB(0, 0), b2, voffB); PG8_STAGE(PG8_SB(0, 1), b2 + hstep, voffB); PG8_STAGE(PG8_SA(0, 0), a2, w0);
            PG8_WAIT_V(8); PG8_WAIT_L(0); PG8_BAR; PG8_MMA(1, 0, At, B0); PG8_MMA(1, 1, At, B1); PG8_BAR; PG8_SCHED;
            PG8_LDB(B0, 1, 0); PG8_LDB(B1, 1, 1); PG8_SCHED; PG8_LDA(At, 1, 0); PG8_STAGE(PG8_SA(0, 1), a2, w1);
            PG8_WAIT_V(8); PG8_WAIT_L(0); PG8_BAR; PG8_MMA(0, 0, At, B0); PG8_MMA(0, 1, At, B1); PG8_BAR; PG8_SCHED;
            PG8_LDA(At, 1, 1); PG8_STAGE(PG8_SB(1, 0), b3, voffB); PG8_STAGE(PG8_SB(1, 1), b3 + hstep, voffB); PG8_STAGE(PG8_SA(1, 0), a3, w0);
            PG8_WAIT_V(8); PG8_WAIT_L(0); PG8_BAR; PG8_MMA(1, 0, At, B0); PG8_MMA(1, 1, At, B1); PG8_BAR; PG8_SCHED;
        }
        if constexpr (ALIGN_EPI) { if (wr == 0) PG8_BAR; }
        if constexpr (FLOW == 1) { if (pub_pm >= 0 && wid == 0 && lane == 0) __hip_atomic_fetch_add(g.rdy + pub_pm, 1u, __ATOMIC_RELAXED, __HIP_MEMORY_SCOPE_AGENT); }
        ride.begin(S.ord(ui), wid, lane);
        Unit nn; bool has2 = false; unsigned rv = 0; (void)has2; (void)rv;
        if constexpr (FLOW == 2) { has2 = S.next(ui + 2, nn); if (has2) rv = __hip_atomic_load(g.rdy + nn.pm, __ATOMIC_RELAXED, __HIP_MEMORY_SCOPE_AGENT); }
        if constexpr (FP8) asm volatile("s_nop 15\n\ts_nop 15" ::: "memory");
        E(acc, cur, ui, wr, wc, fr, fq);
        ride.end(lane);
        if constexpr (FLOW == 2) { if (has2 && (unsigned)__builtin_amdgcn_readfirstlane((int)rv) < (unsigned)FLOW_NEED) flow_wait(g.rdy + nn.pm, FLOW_NEED); }
        if constexpr (FLOW == 1) pub_pm = cur.pm;
        if (!has_next) break;
        if constexpr (has_accbias<Epi>::v) E.init(acc, ui + 1, wc, fq);
        else {
#pragma unroll
        for (int a = 0; a < 2; ++a)
#pragma unroll
            for (int b = 0; b < 2; ++b)
#pragma unroll
                for (int m = 0; m < 4; ++m)
#pragma unroll
                    for (int n = 0; n < 2; ++n) acc[a][b][m][n] = (f32x4){0.f, 0.f, 0.f, 0.f}; }
        cur = nxt; cA = nA; cB = nB; ++ui;
        if constexpr (GATHER) {
#pragma unroll
            for (int h = 0; h < 2; ++h)
#pragma unroll
                for (int i = 0; i < 2; ++i) vc[h][i] = vn[h][i]; }
        if constexpr (ALIGN_EPI) { if (wr == 1) PG8_BAR; }
    }
    PG8_WAIT_V(0);
    if constexpr (!ALIGN_EPI) { if (wr == 0) PG8_BAR; }
    PG8_BAR;
    if constexpr (FLOW == 1) { if (pub_pm >= 0 && wid == 0 && lane == 0) __hip_atomic_fetch_add(g.rdy + pub_pm, 1u, __ATOMIC_RELAXED, __HIP_MEMORY_SCOPE_AGENT); }
#undef PG8_SA
#undef PG8_SB
#undef PG8_STAGE
#undef PG8_LDA
#undef PG8_LDB
#undef PG8_MMA
#undef PG8_CAT
#undef PG8_WAIT_V
#undef PG8_WAIT_L
#undef PG8_BAR
#undef PG8_SCHED
#undef PG8_ROWOFF
}
}
namespace pg8 {
struct EpiInProj0 {
    static constexpr bool PERM = true;
    bf16 *Q0, *K0, *V0, *SG, *U; const float* rope;
    __device__ __forceinline__ void operator()(const f32x4 (&acc)[2][2][4][2], const Unit& u, int, int wr, int wc, int fr, int fq) const {
        const int row0 = u.pm * BM + wr * 64 + fr;
        if (u.pn < 2) {
            bf16* dst = u.pn == 0 ? Q0 : K0; const float sc = u.pn == 0 ? 1.f : 0.125f;
            f32x4 nc0, nc1, ns0, ns1;
            { const float* cp = rope + (row0 & (SEQ - 1)) * 32 + 8 * fq; const float* sp = cp + SEQ * 32; nc0 = *(const f32x4*)cp; nc1 = *(const f32x4*)(cp + 4); ns0 = *(const f32x4*)sp; ns1 = *(const f32x4*)(sp + 4); }
#pragma unroll
            for (int ai = 0; ai < 2; ++ai)
#pragma unroll
                for (int m = 0; m < 4; ++m) {
                    const int row = row0 + ai * HALF + m * 16;
                    const f32x4 c0 = nc0, c1 = nc1, s0 = ns0, s1 = ns1;
                    { const int gi = ai * 4 + m + 1;
                      if (gi < 8) { const int nrow = row0 + (gi >> 2) * HALF + (gi & 3) * 16; const float* cp = rope + (nrow & (SEQ - 1)) * 32 + 8 * fq; const float* sp = cp + SEQ * 32;
                          nc0 = *(const f32x4*)cp; nc1 = *(const f32x4*)(cp + 4); ns0 = *(const f32x4*)sp; ns1 = *(const f32x4*)(sp + 4); } }
                    const f32x4 a0 = acc[ai][0][m][0], a1 = acc[ai][0][m][1], b0 = acc[ai][1][m][0], b1 = acc[ai][1][m][1];
                    const f32x4 o10 = (a0 * c0 - b0 * s0) * sc, o11 = (a1 * c1 - b1 * s1) * sc, o20 = (b0 * c0 + a0 * s0) * sc, o21 = (b1 * c1 + a1 * s1) * sc;
                    bf16* p = dst + (size_t)row * 256 + 64 * wc + 8 * fq;
                    u32x4 w; w.x = cvt_pk_bf16(o10[0], o10[1]); w.y = cvt_pk_bf16(o10[2], o10[3]); w.z = cvt_pk_bf16(o11[0], o11[1]); w.w = cvt_pk_bf16(o11[2], o11[3]);
                    *(u32x4*)p = w;
                    w.x = cvt_pk_bf16(o20[0], o20[1]); w.y = cvt_pk_bf16(o20[2], o20[3]); w.z = cvt_pk_bf16(o21[0], o21[1]); w.w = cvt_pk_bf16(o21[2], o21[3]);
                    *(u32x4*)(p + 32) = w;
                    asm volatile("" ::: "memory");
                }
        } else if (u.pn < 6) {
            const bool isg = u.pn >= 4; bf16* dst = isg ? SG : V0; const int colb = 256 * ((u.pn - 2) & 1) + 32 * wc + 8 * fq;
#pragma unroll
            for (int ai = 0; ai < 2; ++ai)
#pragma unroll
                for (int m = 0; m < 4; ++m) {
                    const int row = row0 + ai * HALF + m * 16;
#pragma unroll
                    for (int bj = 0; bj < 2; ++bj) {
                        f32x4 v0 = acc[ai][bj][m][0], v1 = acc[ai][bj][m][1];
                        if (isg) {
#pragma unroll
                            for (int j = 0; j < 4; ++j) { v0[j] = v0[j] * sigmoidf_(v0[j]); v1[j] = v1[j] * sigmoidf_(v1[j]); } }
                        u32x4 w; w.x = cvt_pk_bf16(v0[0], v0[1]); w.y = cvt_pk_bf16(v0[2], v0[3]); w.z = cvt_pk_bf16(v1[0], v1[1]); w.w = cvt_pk_bf16(v1[2], v1[3]);
                        *(u32x4*)(dst + (size_t)row * 512 + colb + bj * HALF) = w;
                    }
                }
        } else {
            const int ch0 = 128 * (u.pn - 6) + 32 * wc + 8 * fq;
#pragma unroll
            for (int ai = 0; ai < 2; ++ai)
#pragma unroll
                for (int m = 0; m < 4; ++m) {
                    const int row = row0 + ai * HALF + m * 16;
                    f32x4 v0 = acc[ai][0][m][0], v1 = acc[ai][0][m][1]; const f32x4 g0 = acc[ai][1][m][0], g1 = acc[ai][1][m][1];
#pragma unroll
                    for (int j = 0; j < 4; ++j) { v0[j] = v0[j] * sigmoidf_(g0[j]); v1[j] = v1[j] * sigmoidf_(g1[j]); }
                    u32x4 w; w.x = cvt_pk_bf16(v0[0], v0[1]); w.y = cvt_pk_bf16(v0[2], v0[3]); w.z = cvt_pk_bf16(v1[0], v1[1]); w.w = cvt_pk_bf16(v1[2], v1[3]);
                    *(u32x4*)(U + (size_t)row * 512 + ch0) = w;
                }
        }
    }
};
template <bool RB> struct EpiResid {
    static constexpr bool PERM = true;
    const void* xres; bf16* y;
    struct RG { u32x4 w[2]; f32x4 x[2][2]; };
    __device__ __forceinline__ void load(RG& g, size_t off) const {
#pragma unroll
        for (int bj = 0; bj < 2; ++bj) {
            if constexpr (RB) g.w[bj] = *(const u32x4*)((const bf16*)xres + off + bj * HALF);
            else { g.x[bj][0] = *(const f32x4*)((const float*)xres + off + bj * HALF); g.x[bj][1] = *(const f32x4*)((const float*)xres + off + bj * HALF + 4); } }
    }
    __device__ __forceinline__ void operator()(const f32x4 (&acc)[2][2][4][2], const Unit& u, int, int wr, int wc, int fr, int fq) const {
        const int row0 = u.pm * BM + wr * 64 + fr, col0 = u.pn * BM + wc * 32 + 8 * fq;
        RG cur, nx; load(cur, (size_t)row0 * D + col0);
#pragma unroll
        for (int ai = 0; ai < 2; ++ai)
#pragma unroll
            for (int m = 0; m < 4; ++m) { const size_t off = (size_t)(row0 + ai * HALF + m * 16) * D + col0;
                const int gi = ai * 4 + m + 1;
                if (RB && gi < 8) load(nx, (size_t)(row0 + (gi >> 2) * HALF + (gi & 3) * 16) * D + col0);
#pragma unroll
                for (int bj = 0; bj < 2; ++bj) { f32x4 x0, x1;
                    if constexpr (RB) { const u32x4 w = cur.w[bj];
                        x0 = (f32x4){__uint_as_float(w.x << 16), __uint_as_float(w.x & 0xffff0000u), __uint_as_float(w.y << 16), __uint_as_float(w.y & 0xffff0000u)};
                        x1 = (f32x4){__uint_as_float(w.z << 16), __uint_as_float(w.z & 0xffff0000u), __uint_as_float(w.w << 16), __uint_as_float(w.w & 0xffff0000u)}; }
                    else { x0 = cur.x[bj][0]; x1 = cur.x[bj][1]; }
                    const f32x4 v0 = x0 * ALPHA + acc[ai][bj][m][0], v1 = x1 * ALPHA + acc[ai][bj][m][1];
                    u32x4 w; w.x = cvt_pk_bf16(v0[0], v0[1]); w.y = cvt_pk_bf16(v0[2], v0[3]); w.z = cvt_pk_bf16(v1[0], v1[1]); w.w = cvt_pk_bf16(v1[2], v1[3]);
                    *(u32x4*)(y + off + bj * HALF) = w; }
                asm volatile("" ::: "memory");
                if constexpr (RB) cur = nx; else if (gi < 8) load(cur, (size_t)(row0 + (gi >> 2) * HALF + (gi & 3) * 16) * D + col0); }
    }
};
template <bool F8> struct EpiUp {
    static constexpr bool PERM = true, LDSBIAS = true, ACCBIAS = true;
    const float* bup; void* act; LAS float* bl;
    __device__ __forceinline__ const float* bias(const Unit& u) const { return bup + (size_t)u.e * 2 * FF + 256 * u.pn; }
    __device__ __forceinline__ void init(f32x4 (&acc)[2][2][4][2], int ui, int wc, int fq) const {
        const LAS float* bp = bl + (ui % 3) * 256 + 64 * wc + 16 * fq;
        const f32x4 q0 = *(const LAS f32x4*)bp, q1 = *(const LAS f32x4*)(bp + 4), q2 = *(const LAS f32x4*)(bp + 8), q3 = *(const LAS f32x4*)(bp + 12);
        const f32x4 bg0 = {q0[0], q0[2], q1[0], q1[2]}, bl0 = {q0[1], q0[3], q1[1], q1[3]}, bg1 = {q2[0], q2[2], q3[0], q3[2]}, bl1 = {q2[1], q2[3], q3[1], q3[3]};
#pragma unroll
        for (int ai = 0; ai < 2; ++ai)
#pragma unroll
            for (int m = 0; m < 4; ++m) { acc[ai][0][m][0] = bg0; acc[ai][0][m][1] = bg1; acc[ai][1][m][0] = bl0; acc[ai][1][m][1] = bl1; }
    }
    __device__ __forceinline__ void operator()(const f32x4 (&acc)[2][2][4][2], const Unit& u, int ui, int wr, int wc, int fr, int fq) const {
        const int ch0 = 128 * u.pn + 32 * wc + 8 * fq;
        const int row0 = u.pm * BM + wr * 64 + fr;
#pragma unroll
        for (int ai = 0; ai < 2; ++ai)
#pragma unroll
            for (int m = 0; m < 4; ++m) {
                const int row = row0 + ai * HALF + m * 16;
                const f32x4 g0 = swiglu4(acc[ai][0][m][0], acc[ai][1][m][0], F8 ? (float)(1 << SH_ACT) : 1.f), g1 = swiglu4(acc[ai][0][m][1], acc[ai][1][m][1], F8 ? (float)(1 << SH_ACT) : 1.f);
                if constexpr (F8) { u32x2 w; w.x = pk4_fp8_inrange(g0[0], g0[1], g0[2], g0[3]); w.y = pk4_fp8_inrange(g1[0], g1[1], g1[2], g1[3]);
                    *(u32x2*)((unsigned char*)act + (size_t)row * FF + ch0) = w; }
                else { u32x4 w; w.x = cvt_pk_bf16(g0[0], g0[1]); w.y = cvt_pk_bf16(g0[2], g0[3]); w.z = cvt_pk_bf16(g1[0], g1[1]); w.w = cvt_pk_bf16(g1[2], g1[3]);
                    *(u32x4*)((bf16*)act + (size_t)row * FF + ch0) = w; }
                asm volatile("" ::: "memory");
            }
    }
};
struct EpiDown {
    static constexpr bool PERM = true, LDSBIAS = true, ACCBIAS = true;
    const float* bdn; bf16* yslot; const LAS int* ttok; const LAS float* tgate; LAS float* bl;
    __device__ __forceinline__ const float* bias(const Unit& u) const { return bdn + (size_t)u.e * D + 256 * u.pn; }
    __device__ __forceinline__ void init(f32x4 (&acc)[2][2][4][2], int ui, int wc, int fq) const {
#pragma unroll
        for (int bj = 0; bj < 2; ++bj)
#pragma unroll
            for (int n = 0; n < 2; ++n) { const f32x4 bv = *(const LAS f32x4*)(bl + (ui % 3) * 256 + wc * 32 + 8 * fq + bj * HALF + 4 * n);
#pragma unroll
                for (int ai = 0; ai < 2; ++ai)
#pragma unroll
                    for (int m = 0; m < 4; ++m) acc[ai][bj][m][n] = bv; }
    }
    __device__ __forceinline__ void operator()(const f32x4 (&acc)[2][2][4][2], const Unit& u, int ui, int wr, int wc, int fr, int fq) const {
        const int col0 = u.pn * BM + wc * 32 + 8 * fq;
#pragma unroll
        for (int ai = 0; ai < 2; ++ai)
#pragma unroll
            for (int m = 0; m < 4; ++m) {
                const int r = ai * HALF + wr * 64 + m * 16 + fr; const int tok4 = ttok[ui * 256 + r]; const float gt = tgate[ui * 256 + r] * (YS8 ? (float)(1 << SH_Y) : 1.f);
                if (tok4 >= 0) {
#pragma unroll
                    for (int bj = 0; bj < 2; ++bj) { const f32x4 v0 = acc[ai][bj][m][0] * gt, v1 = acc[ai][bj][m][1] * gt;
                        if constexpr (YS8) { u32x2 w; w.x = pk4_fp8(v0[0], v0[1], v0[2], v0[3]); w.y = pk4_fp8(v1[0], v1[1], v1[2], v1[3]);
                            *(u32x2*)((unsigned char*)yslot + (size_t)tok4 * D + col0 + bj * HALF) = w; }
                        else { u32x4 w; w.x = cvt_pk_bf16(v0[0], v0[1]); w.y = cvt_pk_bf16(v0[2], v0[3]); w.z = cvt_pk_bf16(v1[0], v1[1]); w.w = cvt_pk_bf16(v1[2], v1[3]);
                            *(u32x4*)(yslot + (size_t)tok4 * D + col0 + bj * HALF) = w; } }
                }
                asm volatile("" ::: "memory");
            }
    }
};
struct EpiBf16 {
    static constexpr bool PERM = true;
    bf16* O; int ldc; int split_cols; size_t split_stride; float scale0;
    __device__ __forceinline__ void operator()(const f32x4 (&acc)[2][2][4][2], const Unit& u, int, int wr, int wc, int fr, int fq) const {
        const int row0 = u.pm * BM + wr * 64 + fr; int colt = u.pn * BM; bf16* base = O; float sc = 1.f;
        if (split_cols) { const int t = colt / split_cols; base += (size_t)t * split_stride; colt -= t * split_cols; if (t == 0) sc = scale0; }
        const int col0 = colt + wc * 32 + 8 * fq;
#pragma unroll
        for (int ai = 0; ai < 2; ++ai)
#pragma unroll
            for (int m = 0; m < 4; ++m) { bf16* rowp = base + (size_t)(row0 + ai * HALF + m * 16) * ldc + col0;
#pragma unroll
                for (int bj = 0; bj < 2; ++bj) { const f32x4 v0 = acc[ai][bj][m][0] * sc, v1 = acc[ai][bj][m][1] * sc;
                    u32x4 w; w.x = cvt_pk_bf16(v0[0], v0[1]); w.y = cvt_pk_bf16(v0[2], v0[3]); w.z = cvt_pk_bf16(v1[0], v1[1]); w.w = cvt_pk_bf16(v1[2], v1[3]);
                    *(u32x4*)(rowp + bj * HALF) = w; } }
    }
};
__device__ __forceinline__ int pi32(int r) { return (r & 0x13) | ((r & 4) << 1) | ((r & 8) >> 1); }
struct EpiQK {
    static constexpr bool PERM = true;
    bf16* Q; bf16* Kf; float qscale;
    __device__ __forceinline__ void operator()(const f32x4 (&acc)[2][2][4][2], const Unit& u, int, int wr, int wc, int fr, int fq) const {
        const int row0 = u.pm * BM + wr * 64 + fr; const bool isk = u.pn >= 4; const int colt = (u.pn & 3) * BM + wc * 32 + 8 * fq; const float sc = isk ? 1.f : qscale;
#pragma unroll
        for (int ai = 0; ai < 2; ++ai)
#pragma unroll
            for (int m = 0; m < 4; ++m) { const int row = row0 + ai * HALF + m * 16;
#pragma unroll
                for (int bj = 0; bj < 2; ++bj) { const f32x4 v0 = acc[ai][bj][m][0] * sc, v1 = acc[ai][bj][m][1] * sc; const int col = colt + bj * HALF;
                    u32x4 w; w.x = cvt_pk_bf16(v0[0], v0[1]); w.y = cvt_pk_bf16(v0[2], v0[3]); w.z = cvt_pk_bf16(v1[0], v1[1]); w.w = cvt_pk_bf16(v1[2], v1[3]);
                    if (isk) { const int b = row >> 12, t = row & (SEQ - 1), h = col >> 7, c16 = (col & 127) >> 3;
                        *(u32x4*)(Kf + ((size_t)(b * 8 + h) * SEQ + (t & ~31)) * 128 + ((c16 >> 1) * 64 + (c16 & 1) * 32 + pi32(t & 31)) * 8) = w; }
                    else *(u32x4*)(Q + (size_t)row * D + col) = w; } }
    }
};
struct EpiVT {
    static constexpr bool PERM = true;
    bf16* Vf;
    __device__ __forceinline__ void operator()(const f32x4 (&acc)[2][2][4][2], const Unit& u, int, int wr, int wc, int fr, int fq) const {
        const int row0 = u.pm * BM + wr * 64 + fr, colt = u.pn * BM + wc * 32 + 8 * fq;
#pragma unroll
        for (int ai = 0; ai < 2; ++ai)
#pragma unroll
            for (int m = 0; m < 4; ++m) { const int row = row0 + ai * HALF + m * 16, h = row >> 7, e = row & 127;
#pragma unroll
                for (int bj = 0; bj < 2; ++bj) { const f32x4 v0 = acc[ai][bj][m][0], v1 = acc[ai][bj][m][1]; const int tok = colt + bj * HALF, b = tok >> 12, t = tok & (SEQ - 1);
                    u32x4 w; w.x = cvt_pk_bf16(v0[0], v0[1]); w.y = cvt_pk_bf16(v0[2], v0[3]); w.z = cvt_pk_bf16(v1[0], v1[1]); w.w = cvt_pk_bf16(v1[2], v1[3]);
                    *(u32x4*)(Vf + ((size_t)(b * 8 + h) * SEQ + (t & ~31)) * 128 + ((((t >> 4) & 1) * 4 + (e >> 5)) * 64 + ((t >> 3) & 1) * 32 + (e & 31)) * 8) = w; } }
    }
};
}

typedef GAS unsigned gu32;
#define RLX_AGENT __ATOMIC_RELAXED, __HIP_MEMORY_SCOPE_AGENT
#define LDS_WAIT() asm volatile("s_waitcnt lgkmcnt(0)" ::: "memory")
#define VM_WAIT() asm volatile("s_waitcnt vmcnt(0)" ::: "memory")
#define XB_TMO      128
#define XB_XCNT(j)  (256  + 64 * (j))
#define XB_XSUB(j)  (1280 + 64 * (j))
#define XB_XGEN(j)  (2304 + 64 * (j))
#define XB_TOP      3328
#define XB_TOPGEN   3392
#define XCD_BAR_WORDS 3456
#define XB_SPIN_CAP (1u << 18)
__device__ __forceinline__ unsigned xb_ld(unsigned* p)              { return __hip_atomic_load(p, __ATOMIC_RELAXED, __HIP_MEMORY_SCOPE_AGENT); }
__device__ __forceinline__ unsigned xb_add(unsigned* p, unsigned v) { return __hip_atomic_fetch_add(p, v, __ATOMIC_RELAXED, __HIP_MEMORY_SCOPE_AGENT); }
__device__ __forceinline__ unsigned xb_xcc_id() { return (unsigned)__builtin_amdgcn_s_getreg((3 << 11) | 20) & 0xFu; }
#define XB_SPIN(cond, bar) do { unsigned _sp = 0; while (cond) { __builtin_amdgcn_s_sleep(1); \
    if ((++_sp & 255u) == 0u) { if (xb_ld(&(bar)[XB_TMO])) break; if (_sp > XB_SPIN_CAP) { atomicAdd(&(bar)[XB_TMO], 1u); break; } } } } while (0)
struct XcdBarrier { unsigned* bar; unsigned x; volatile LAS unsigned* st; };
__device__ __forceinline__ XcdBarrier xcd_barrier_post(unsigned* bar, volatile LAS unsigned* st) {
    XcdBarrier b; b.bar = bar; b.x = xb_xcc_id(); b.st = st;
    if (threadIdx.x == 0) { const unsigned rank = xb_add(&bar[XB_XCNT(b.x)], 1u); st[2] = rank; st[3] = b.x; }
    return b;
}
__device__ __forceinline__ void xcd_barrier_complete(unsigned* bar, unsigned x, unsigned& nloc, unsigned& nx) {
    const unsigned G = gridDim.x * gridDim.y * gridDim.z;
    unsigned sum, cnt, mine, sp = 0u;
    for (;;) {
        sum = 0u; cnt = 0u; mine = 0u;
#pragma unroll
        for (unsigned j = 0; j < 16; ++j) { const unsigned c = xb_ld(&bar[XB_XCNT(j)]); sum += c; cnt += (c > 0u) ? 1u : 0u; mine = (j == x) ? c : mine; }
        if (sum == G) break;
        __builtin_amdgcn_s_sleep(1);
        if ((++sp & 255u) == 0u) { if (xb_ld(&bar[XB_TMO])) break; if (sp > XB_SPIN_CAP) { atomicAdd(&bar[XB_TMO], 1u); break; } }
    }
    nloc = mine > 0u ? mine : 1u; nx = cnt > 0u ? cnt : 1u;
}
__device__ __forceinline__ void xcd_barrier(const XcdBarrier& b) {
    asm volatile("s_waitcnt vmcnt(0)" ::: "memory");
    __syncthreads();
    if (threadIdx.x == 0) {
        unsigned* bar = b.bar;
        __builtin_amdgcn_s_waitcnt(0);
        unsigned nloc = b.st[0], nx = b.st[1];
        if (nloc == 0u) { xcd_barrier_complete(bar, b.x, nloc, nx); b.st[0] = nloc; b.st[1] = nx; }
        const unsigned old = xb_add(&bar[XB_XSUB(b.x)], 1u);
        const unsigned gen = old / nloc;
        if (old + 1u == (gen + 1u) * nloc) {
            __builtin_amdgcn_fence(__ATOMIC_RELEASE, "agent");
            asm volatile("s_waitcnt vmcnt(0)" ::: "memory");
            const unsigned og = xb_add(&bar[XB_TOP], 1u);
            const unsigned tg = og / nx;
            if (og + 1u == (tg + 1u) * nx) xb_add(&bar[XB_TOPGEN], 1u);
            else XB_SPIN(xb_ld(&bar[XB_TOPGEN]) == tg, bar);
            __builtin_amdgcn_fence(__ATOMIC_ACQUIRE, "agent");
            xb_add(&bar[XB_XGEN(b.x)], 1u);
            asm volatile("s_waitcnt vmcnt(0)" ::: "memory");
        } else {
            XB_SPIN(xb_ld(&bar[XB_XGEN(b.x)]) == gen, bar);
            __builtin_amdgcn_fence(__ATOMIC_ACQUIRE, "agent");
            asm volatile("s_waitcnt vmcnt(0)" ::: "memory");
        }
    }
    __syncthreads();
}
constexpr int NWAVES = 8;
constexpr int RING_OFF = 0, RING_BYTES = 131072;
constexpr int AUX_OFF = 131072, AUX_BYTES = 15360;
constexpr int LCTL_OFF = AUX_OFF + AUX_BYTES;
constexpr int LDS_BYTES = 147456;
static_assert(LCTL_OFF + 1024 == LDS_BYTES, "LDS map");

struct Params { const float* in[30]; float* out; unsigned char* ws; int ph_lo, ph_hi, li, pad; };

struct Frame { LAS unsigned char* lds; int G, bid, wave, xok; };
typedef const __attribute__((address_space(4))) Params* KParams;
__device__ __forceinline__ KParams kargs() { KParams p = (KParams)__builtin_amdgcn_kernarg_segment_ptr(); asm volatile("" : "+s"(p)); return p; }
#define PHASE_PROLOGUE() int lane_ = (int)__builtin_amdgcn_mbcnt_hi(~0u, __builtin_amdgcn_mbcnt_lo(~0u, 0u)); asm volatile("" : "+v"(lane_)); const int lane = lane_, wave = F.wave, tid = wave * 64 + lane; \
    KParams P = kargs(); unsigned char* const ws = P->ws; unsigned* const ctl = (unsigned*)(ws + WS_CTL); (void)tid; (void)ctl
#define WSP(T, off) ((T*)(ws + (off)))

__device__ __forceinline__ int rowmap(int kind, int n) {
    if (kind == 1) {
        if (n < 512) { const int base = n & 256, r = n & 255, h = r >> 6, bj = (r >> 5) & 1, dd = r & 31; return base + 128 * bj + 32 * h + dd; }
        if (n < 1536) return n;
        if (n < 2048) { const int i = n - 1536; return 1536 + 256 * (i >> 7) + (i & 127); }
        const int i = n - 2048; return 1536 + 256 * (i >> 7) + 128 + (i & 127);
    }
    if (kind == 2) { const int ch = n >> 1; return 256 * (ch >> 7) + 128 * (n & 1) + (ch & 127); }
    return n;
}
__device__ __forceinline__ void p0_item(const float* W, int K, int N, bf16* WT, int kind, LAS float* scr, int kb, int nb, int lane) {
    const int k0 = 64 * kb, n0 = 64 * nb;
    f32x4 v[16];
#pragma unroll
    for (int i = 0; i < 16; ++i) v[i] = *(const f32x4*)(W + (size_t)(k0 + 4 * i + (lane >> 4)) * N + n0 + 4 * (lane & 15));
#pragma unroll
    for (int i = 0; i < 16; ++i) { LAS float* s = scr + (4 * i + (lane >> 4)) * 65 + 4 * (lane & 15); s[0] = v[i][0]; s[1] = v[i][1]; s[2] = v[i][2]; s[3] = v[i][3]; }
    LDS_WAIT(); asm volatile("" ::: "memory");
    const int c = lane & 7;
#pragma unroll
    for (int j = 0; j < 8; ++j) { const int n = (lane >> 3) + 8 * j; const LAS float* s = scr + (8 * c) * 65 + n;
        u32x4 o; o.x = pk2(s[0], s[65]); o.y = pk2(s[130], s[195]); o.z = pk2(s[260], s[325]); o.w = pk2(s[390], s[455]);
        *(u32x4*)(WT + (size_t)rowmap(kind, n0 + n) * K + k0 + 8 * c) = o; }
    LDS_WAIT(); asm volatile("" ::: "memory");
}
constexpr int I_UP = NE * 16 * 32, I_DN = NE * 16 * 16, MOE_ITEMS_L = I_UP + I_DN, MOE_ITEMS = 2 * MOE_ITEMS_L;
struct ItemD { const float* W; unsigned char* WT; int N, kind, sh, k0, n0; };
__device__ __forceinline__ ItemD moe_item_desc(KParams P, unsigned char* ws, int idx) {
    ItemD d; const int l = idx >= MOE_ITEMS_L; int r = idx - l * MOE_ITEMS_L;
    if (r < I_UP) { const int e = r >> 9, q = r & 511; d.W = P->in[l ? 24 : 12] + (size_t)e * D * 2 * FF; d.WT = ws + (l ? WS_WUP1 : WS_WUP0) + (size_t)e * 2 * FF * D; d.N = 2 * FF; d.kind = 2; d.sh = SH_WUP; d.k0 = 64 * (q >> 5); d.n0 = 64 * (q & 31); }
    else { r -= I_UP; const int e = r >> 8, q = r & 255; d.W = P->in[l ? 26 : 14] + (size_t)e * FF * D; d.WT = ws + (l ? WS_WDN1 : WS_WDN0) + (size_t)e * D * FF; d.N = D; d.kind = 0; d.sh = SH_WDN; d.k0 = 64 * (q >> 4); d.n0 = 64 * (q & 15); }
    return d;
}
__device__ __forceinline__ void item8_load(f32x4 (&v)[16], const ItemD& d, int lane) {
#pragma unroll
    for (int i = 0; i < 16; ++i) v[i] = __builtin_nontemporal_load((const f32x4*)(d.W + (size_t)(d.k0 + 16 * (lane >> 4) + i) * d.N + d.n0 + 4 * (lane & 15)));
}
__device__ __forceinline__ void item8_finish(const f32x4 (&v)[16], const ItemD& d, int lane) {
    const float sc = (float)(1 << d.sh);
#pragma unroll
    for (int j = 0; j < 4; ++j) { u32x4 w;
        w.x = pk4_fp8(v[0][j] * sc, v[1][j] * sc, v[2][j] * sc, v[3][j] * sc); w.y = pk4_fp8(v[4][j] * sc, v[5][j] * sc, v[6][j] * sc, v[7][j] * sc);
        w.z = pk4_fp8(v[8][j] * sc, v[9][j] * sc, v[10][j] * sc, v[11][j] * sc); w.w = pk4_fp8(v[12][j] * sc, v[13][j] * sc, v[14][j] * sc, v[15][j] * sc);
        *(u32x4*)(d.WT + (size_t)rowmap(d.kind, d.n0 + 4 * (lane & 15) + j) * 1024 + d.k0 + 16 * (lane >> 4)) = w; }
}
struct MoeRide {
    KParams P; unsigned char* ws; int base, limit; ItemD d; f32x4 v[16]; bool ok;
    __device__ __forceinline__ void begin(int L, int w, int lane) { asm volatile("" : "+v"(lane));
        const int idx = base + 8 * L + w; ok = idx < limit; d = moe_item_desc(P, ws, ok ? idx : limit - 1);
        if (ok) item8_load(v, d, lane); else {
#pragma unroll
            for (int i = 0; i < 16; ++i) v[i] = (f32x4){0.f, 0.f, 0.f, 0.f}; } }
    __device__ __forceinline__ void end(int lane) { if (ok) item8_finish(v, d, lane); }
};
__device__ __forceinline__ void moe_convert(Frame& F, int first, int n, int stride, int limit) {
    PHASE_PROLOGUE();
    if (n > 0 && first + (n - 1) * stride >= limit) n = (limit - first + stride - 1) / stride;
    if (n <= 0) return;
    f32x4 vc[16], vn[16];
    ItemD dc = moe_item_desc(P, ws, first), dn = dc;
    item8_load(vc, dc, lane);
    for (int k = 0; k < n; ++k) {
        const bool more = k + 1 < n;
        if (more) { dn = moe_item_desc(P, ws, first + (k + 1) * stride); item8_load(vn, dn, lane); }
        item8_finish(vc, dc, lane);
        if (more) { dc = dn;
#pragma unroll
            for (int i = 0; i < 16; ++i) vc[i] = vn[i]; }
    }
}
__device__ __forceinline__ void p0_item8(const float* W, int K, int N, unsigned char* WT, int kind, int sh, LAS float* scr, int kb, int nb, int lane) {
    const int k0 = 64 * kb, n0 = 64 * nb;
    f32x4 v[16];
#pragma unroll
    for (int i = 0; i < 16; ++i) v[i] = *(const f32x4*)(W + (size_t)(k0 + 4 * i + (lane >> 4)) * N + n0 + 4 * (lane & 15));
#pragma unroll
    for (int i = 0; i < 16; ++i) { LAS float* s = scr + (4 * i + (lane >> 4)) * 65 + 4 * (lane & 15); s[0] = v[i][0]; s[1] = v[i][1]; s[2] = v[i][2]; s[3] = v[i][3]; }
    LDS_WAIT(); asm volatile("" ::: "memory");
    const float sc = (float)(1 << sh); const LAS float* s = scr + lane;
    unsigned char* o = WT + (size_t)rowmap(kind, n0 + lane) * K + k0;
#pragma unroll
    for (int j = 0; j < 4; ++j) { u32x4 w;
        w.x = pk4_fp8(s[(16 * j + 0) * 65] * sc, s[(16 * j + 1) * 65] * sc, s[(16 * j + 2) * 65] * sc, s[(16 * j + 3) * 65] * sc);
        w.y = pk4_fp8(s[(16 * j + 4) * 65] * sc, s[(16 * j + 5) * 65] * sc, s[(16 * j + 6) * 65] * sc, s[(16 * j + 7) * 65] * sc);
        w.z = pk4_fp8(s[(16 * j + 8) * 65] * sc, s[(16 * j + 9) * 65] * sc, s[(16 * j + 10) * 65] * sc, s[(16 * j + 11) * 65] * sc);
        w.w = pk4_fp8(s[(16 * j + 12) * 65] * sc, s[(16 * j + 13) * 65] * sc, s[(16 * j + 14) * 65] * sc, s[(16 * j + 15) * 65] * sc);
        *(u32x4*)(o + 16 * j) = w; }
    LDS_WAIT(); asm volatile("" ::: "memory");
}
constexpr int CONV_C1 = 64, CONV_P2 = 1024 * 8, CONV_A0 = MOE_ITEMS_L - 128 * CONV_C1 - CONV_P2;
__device__ __forceinline__ void p0_prep(Frame& F) {
    PHASE_PROLOGUE();
    LAS float* scr = (LAS float*)(F.lds + wave * 16640);
    const int gw = F.bid * NWAVES + wave, NGW = F.G * NWAVES;
    constexpr int I_IN0 = 16 * 40, I_O = 16 * 16, I_IN1 = 16 * 48;
    constexpr int NITEMS = I_IN0 + 2 * I_O + I_IN1;
    for (int it = gw; it < NITEMS; it += NGW) {
        int r = it;
        if (r < I_IN0) { p0_item(P->in[1], D, L0N, WSP(bf16, WS_WIN0), 1, scr, r / 40, r % 40, lane); continue; } r -= I_IN0;
        if (r < I_O) { p0_item8(P->in[7], D, D, WSP(unsigned char, WS_WOUT0), 0, SH_WOUT, scr, r >> 4, r & 15, lane); continue; } r -= I_O;
        if (r < I_IN1) { p0_item(P->in[18], D, 3 * D, WSP(bf16, WS_WIN1), 0, scr, r / 48, r % 48, lane); continue; } r -= I_IN1;
        p0_item8(P->in[19], D, D, WSP(unsigned char, WS_WOUT1), 0, SH_WOUT, scr, r >> 4, r & 15, lane);
    }
    static_assert(MOE_FP8[0] && MOE_FP8[1], "the conversion schedule assumes fp8 expert weights in both layers");
    moe_convert(F, gw, (CONV_A0 - gw + NGW - 1) / NGW, NGW, CONV_A0);
    { const float* x = P->in[0]; bf16* xb = WSP(bf16, WS_XBF);
      for (int m = gw; m < M; m += 4 * NGW) {
          f32x4 v[4][4];
#pragma unroll
          for (int q = 0; q < 4; ++q) { const f32x4* xr = (const f32x4*)(x + (size_t)(m + q * NGW) * D) + lane;
#pragma unroll
              for (int j = 0; j < 4; ++j) v[q][j] = xr[64 * j]; }
#pragma unroll
          for (int q = 0; q < 4; ++q) { u32x2* o = (u32x2*)(xb + (size_t)(m + q * NGW) * D) + lane;
#pragma unroll
              for (int j = 0; j < 4; ++j) { u32x2 w; w.x = pk2(v[q][j][0], v[q][j][1]); w.y = pk2(v[q][j][2], v[q][j][3]); o[64 * j] = w; } } } }
    static_assert(M % (4 * 2048) == 0, "bf16(x) loop: rows per trip");
    { bf16* rwf = WSP(bf16, WS_RWT);
      for (int i = gw * 64 + lane; i < 2 * 64 * 64; i += NGW * 64) { const int l = i >> 12, s = (i >> 6) & 63, ln = i & 63, e = ln & 31, h = ln >> 5; const float* rw = P->in[l ? 22 : 10];
          u32x4 hi4, lo4; unsigned hw[8], lw[8];
#pragma unroll
          for (int j = 0; j < 8; ++j) { const float w = rw[(16 * s + 8 * h + j) * NE + e]; const unsigned hb = f2bf(w); hw[j] = hb; lw[j] = f2bf(w - __uint_as_float(hb << 16)); }
          hi4.x = hw[0] | (hw[1] << 16); hi4.y = hw[2] | (hw[3] << 16); hi4.z = hw[4] | (hw[5] << 16); hi4.w = hw[6] | (hw[7] << 16);
          lo4.x = lw[0] | (lw[1] << 16); lo4.y = lw[2] | (lw[3] << 16); lo4.z = lw[4] | (lw[5] << 16); lo4.w = lw[6] | (lw[7] << 16);
          *(u32x4*)(rwf + ((size_t)(l * 2 + 0) * 4096 + s * 64 + ln) * 8) = hi4; *(u32x4*)(rwf + ((size_t)(l * 2 + 1) * 4096 + s * 64 + ln) * 8) = lo4; } }
    { float* rope = WSP(float, WS_ROPE);
      for (int i = gw * 64 + lane; i < SEQ * 32; i += NGW * 64) { const int pos = i >> 5, d = i & 31;
          const float inv = powf(10000.f, -(float)d / 32.f); const float ang = (float)pos * inv; rope[i] = cosf(ang); rope[SEQ * 32 + i] = sinf(ang); } }
}

__device__ __forceinline__ int crow(int r, int hi) { return (r & 3) + 8 * (r >> 2) + 4 * hi; }
__device__ __forceinline__ float head_log2g(int hd) { return log2f(1.f - exp2f(-5.f - (float)hd)); }

__device__ __forceinline__ void p2_kv_unit(Frame& F, int unit, int item) {
    PHASE_PROLOGUE();
    ItemD cd = moe_item_desc(P, ws, item); f32x4 cv[16]; item8_load(cv, cd, lane);
    const int bh = unit >> 6, c = unit & 63, b = bh >> 2, hd = bh & 3, r = lane & 31, h = lane >> 5, et = wave >> 1, dt = wave & 1;
    const bf16* K0 = WSP(bf16, WS_K0); const bf16* V0 = WSP(bf16, WS_V0); float* KV = WSP(float, WS_KV);
    const float l2g = head_log2g(hd);
    const size_t row0 = (size_t)b * SEQ + 64 * c;
    f32x16 acc = {};
#pragma unroll
    for (int s = 0; s < 4; ++s) {
        bf16x8 a, bb;
#pragma unroll
        for (int j = 0; j < 8; ++j) { const int m = 16 * s + 8 * h + j;
            a[j] = (short)V0[(row0 + m) * 512 + hd * 128 + 32 * et + r];
            const float kz = bf2f(K0[(row0 + m) * 256 + hd * 64 + 32 * dt + r]) * __builtin_amdgcn_exp2f((float)(63 - m) * l2g);
            bb[j] = (short)f2bf(kz); }
        acc = __builtin_amdgcn_mfma_f32_32x32x16_bf16(a, bb, acc, 0, 0, 0);
    }
    float* o = KV + ((size_t)unit * 128 + 32 * et) * 64 + 32 * dt + r;
#pragma unroll
    for (int g = 0; g < 16; ++g) o[crow(g, h) * 64] = acc[g];
    item8_finish(cv, cd, lane);
}
__device__ __forceinline__ void p2_scan(Frame& F) {
    PHASE_PROLOGUE();
    const float* KV = WSP(float, WS_KV); bf16* RT = WSP(bf16, WS_RT);
    for (int gid = F.bid * 512 + tid; gid < 16 * 8192; gid += F.G * 512) {
        const int bh = gid >> 13, rem = gid & 8191; const float gc = exp2f(64.f * head_log2g(bh & 3));
        float R = 0.f;
        float kv[16], kn[16];
#pragma unroll
        for (int i = 0; i < 16; ++i) kv[i] = KV[((size_t)(bh * 64 + i)) * 8192 + rem];
#pragma unroll
        for (int c0 = 0; c0 < 64; c0 += 16) {
            if (c0 + 16 < 64) {
#pragma unroll
                for (int i = 0; i < 16; ++i) kn[i] = KV[((size_t)(bh * 64 + c0 + 16 + i)) * 8192 + rem]; }
#pragma unroll
            for (int i = 0; i < 16; ++i) { RT[((size_t)(bh * 64 + c0 + i)) * 8192 + rem] = (bf16)f2bf(R); R = gc * R + kv[i]; }
#pragma unroll
            for (int i = 0; i < 16; ++i) kv[i] = kn[i];
        }
    }
}
__device__ __forceinline__ void p2_ret_wave(Frame& F, int wu) {
    PHASE_PROLOGUE();
    const int unit = wu >> 1, nt = wu & 1, bh = unit >> 6, c = unit & 63, b = bh >> 2, hd = bh & 3, r = lane & 31, h = lane >> 5;
    const bf16* Q0 = WSP(bf16, WS_Q0); const bf16* K0 = WSP(bf16, WS_K0); const bf16* V0 = WSP(bf16, WS_V0); const bf16* SG = WSP(bf16, WS_SG); const bf16* RT = WSP(bf16, WS_RT);
    bf16* mix = WSP(bf16, WS_MIX); const float* gng = P->in[2];
    const float l2g = head_log2g(hd);
    const size_t row0 = (size_t)b * SEQ + 64 * c;
    bf16x8 qf[4], kf[2][4], rf[4][4];
#pragma unroll
    for (int s = 0; s < 4; ++s) qf[s] = *(const bf16x8*)(Q0 + (row0 + 32 * nt + r) * 256 + hd * 64 + 16 * s + 8 * h);
#pragma unroll
    for (int et = 0; et < 4; ++et)
#pragma unroll
        for (int s = 0; s < 4; ++s) rf[et][s] = *(const bf16x8*)(RT + ((size_t)unit * 128 + 32 * et + r) * 64 + 16 * s + 8 * h);
#pragma unroll
    for (int mt = 0; mt < 2; ++mt)
#pragma unroll
        for (int s = 0; s < 4; ++s) kf[mt][s] = *(const bf16x8*)(K0 + (row0 + 32 * mt + r) * 256 + hd * 64 + 16 * s + 8 * h);
    __builtin_amdgcn_sched_barrier(0);
    f32x16 o[4];
#pragma unroll
    for (int et = 0; et < 4; ++et) { o[et] = (f32x16){};
#pragma unroll
        for (int s = 0; s < 4; ++s) o[et] = __builtin_amdgcn_mfma_f32_32x32x16_bf16(qf[s], rf[et][s], o[et], 0, 0, 0); }
    __builtin_amdgcn_sched_barrier(0);
    bf16x8 va[4], vb[4];
#define P2C_VLOAD(dst, mt_, s_) do { _Pragma("unroll") for (int et = 0; et < 4; ++et) { _Pragma("unroll") for (int j = 0; j < 8; ++j) { \
        const int m = 32 * (mt_) + 16 * (s_) + 8 * (j >> 2) + 4 * h + (j & 3); dst[et][j] = (short)V0[(row0 + m) * 512 + hd * 128 + 32 * et + r]; } } } while (0)
    P2C_VLOAD(va, 0, 0);
#pragma unroll
    for (int g = 0; g < 16; ++g) { const float xi = __builtin_amdgcn_exp2f((float)(32 * nt + crow(g, h) + 1) * l2g);
#pragma unroll
        for (int et = 0; et < 4; ++et) o[et][g] *= xi; }
#pragma unroll
    for (int mt = 0; mt < 2; ++mt) {
        f32x16 st = {};
#pragma unroll
        for (int s = 0; s < 4; ++s) st = __builtin_amdgcn_mfma_f32_32x32x16_bf16(kf[mt][s], qf[s], st, 0, 0, 0);
#pragma unroll
        for (int g = 0; g < 16; ++g) { const int dist = (32 * nt + r) - (32 * mt + crow(g, h)); st[g] *= __builtin_amdgcn_exp2f(fabsf((float)dist) * l2g); }
#pragma unroll
        for (int s = 0; s < 2; ++s) {
            u32x4 pw; pw.x = cvt_pk_bf16(st[8 * s + 0], st[8 * s + 1]); pw.y = cvt_pk_bf16(st[8 * s + 2], st[8 * s + 3]); pw.z = cvt_pk_bf16(st[8 * s + 4], st[8 * s + 5]); pw.w = cvt_pk_bf16(st[8 * s + 6], st[8 * s + 7]);
            if (mt * 2 + s < 3) { P2C_VLOAD(vb, (mt * 2 + s + 1) >> 1, (mt * 2 + s + 1) & 1); }
            __builtin_amdgcn_sched_barrier(0);
#pragma unroll
            for (int et = 0; et < 4; ++et) o[et] = __builtin_amdgcn_mfma_f32_32x32x16_bf16(__builtin_bit_cast(bf16x8, pw), va[et], o[et], 0, 0, 0);
            __builtin_amdgcn_sched_barrier(0);
#pragma unroll
            for (int et = 0; et < 4; ++et) va[et] = vb[et];
        }
    }
#undef P2C_VLOAD
    float sgv[4][16], ggv[4];
#pragma unroll
    for (int et = 0; et < 4; ++et) { ggv[et] = gng[hd * 128 + 32 * et + r];
#pragma unroll
        for (int g = 0; g < 16; ++g) sgv[et][g] = bf2f(SG[(row0 + 32 * nt + crow(g, h)) * 512 + hd * 128 + 32 * et + r]); }
    __builtin_amdgcn_sched_barrier(0);
    float mu[16], rs[16];
#pragma unroll
    for (int g = 0; g < 16; ++g) { float a = (o[0][g] + o[1][g]) + (o[2][g] + o[3][g]), q = (o[0][g] * o[0][g] + o[1][g] * o[1][g]) + (o[2][g] * o[2][g] + o[3][g] * o[3][g]);
        a = half32_sum(a); q = half32_sum(q);
        mu[g] = a * (1.f / 128.f); rs[g] = rsqrtf(fmaxf(q * (1.f / 128.f) - mu[g] * mu[g], 0.f) + LN_EPS); }
#pragma unroll
    for (int et = 0; et < 4; ++et) {
#pragma unroll
        for (int g = 0; g < 16; ++g) { const size_t row = row0 + 32 * nt + crow(g, h);
            ((unsigned char*)mix)[row * D + hd * 128 + 32 * et + r] = fp8_1((o[et][g] - mu[g]) * rs[g] * ggv[et] * sgv[et][g] * (float)(1 << SH_MIX)); } }
}
__device__ __forceinline__ void p2_conv_unit(Frame& F, int u) {
    PHASE_PROLOGUE();
    const bf16* U = WSP(bf16, WS_U); bf16* mix = WSP(bf16, WS_MIX);
    const float* cw = P->in[3]; const float* cb = P->in[4]; const float* lg = P->in[5]; const float* lb = P->in[6];
    const int r0 = 64 * u, t0 = r0 & (SEQ - 1), ch = tid;
    LAS float* Y = (LAS float*)(F.lds + RING_OFF);
    float w[31];
#pragma unroll
    for (int j = 0; j < 31; ++j) w[j] = cw[j * 512 + ch];
    const float cbias = cb[ch];
    for (int q = 0; q < 2; ++q) {
        float val[62];
#pragma unroll
        for (int i = 0; i < 62; ++i) { const int rel = 32 * q + i - 30; const bool ok = t0 + rel >= 0;
            const float x = bf2f(U[(size_t)(r0 + (ok ? rel : 0)) * 512 + ch]); val[i] = ok ? x : 0.f; }
        __builtin_amdgcn_sched_barrier(0);
#pragma unroll
        for (int o = 0; o < 32; ++o) { float a = cbias;
#pragma unroll
            for (int j = 0; j < 31; ++j) a += w[j] * val[o + j];
            Y[(32 * q + o) * 512 + ch] = a; }
    }
    __syncthreads();
    const f32x4 g0 = *(const f32x4*)(lg + 8 * lane), g1 = *(const f32x4*)(lg + 8 * lane + 4), b0 = *(const f32x4*)(lb + 8 * lane), b1 = *(const f32x4*)(lb + 8 * lane + 4);
    for (int tt = 0; tt < 8; ++tt) {
        const int tok = wave * 8 + tt; const LAS float* yr = Y + tok * 512 + 8 * lane;
        f32x4 a = *(const LAS f32x4*)yr, c = *(const LAS f32x4*)(yr + 4);
        const float mu = wave_sum((a[0] + a[1]) + (a[2] + a[3]) + (c[0] + c[1]) + (c[2] + c[3])) * (1.f / 512.f);
        a = a - mu; c = c - mu;
        const float var = wave_sum((a[0] * a[0] + a[1] * a[1]) + (a[2] * a[2] + a[3] * a[3]) + (c[0] * c[0] + c[1] * c[1]) + (c[2] * c[2] + c[3] * c[3])) * (1.f / 512.f);
        const float rstd = rsqrtf(var + LN_EPS);
        a = a * rstd * g0 + b0; c = c * rstd * g1 + b1;
#pragma unroll
        for (int j = 0; j < 4; ++j) { a[j] = a[j] * sigmoidf_(a[j]); c[j] = c[j] * sigmoidf_(c[j]); }
        const float sm = (float)(1 << SH_MIX);
        u32x2 o; o.x = pk4_fp8(a[0] * sm, a[1] * sm, a[2] * sm, a[3] * sm); o.y = pk4_fp8(c[0] * sm, c[1] * sm, c[2] * sm, c[3] * sm);
        *(u32x2*)((unsigned char*)mix + (size_t)(r0 + tok) * D + 512 + 8 * lane) = o;
    }
    __syncthreads();
}

constexpr int RT_RS = 1032;
constexpr int RT_XL = 32 * RT_RS * 2, RT_PART = 0, RT_LOG = 8 * 32 * 32 * 4, RT_SMALL = AUX_OFF + 4096;
__device__ __forceinline__ void p_router(Frame& F, int layer) {
    PHASE_PROLOGUE();
    const bf16* ypre = WSP(bf16, WS_YPRE); unsigned char* x1f8 = WSP(unsigned char, WS_X1F8);
    const float* g = P->in[layer ? 20 : 8]; const float* bb = P->in[layer ? 21 : 9]; const float* rb = P->in[layer ? 23 : 11];
    const bf16* rwh = WSP(bf16, WS_RWT) + (size_t)(layer * 2) * 4096 * 8; const bf16* rwl = rwh + 4096 * 8;
    unsigned* cnt = ctl + CW_CNT + layer * 2048; int* rowtok = WSP(int, WS_ROWTOK); float* rowgate = WSP(float, WS_ROWGATE);
    LAS bf16* XH = (LAS bf16*)(F.lds); LAS bf16* XL = (LAS bf16*)(F.lds + RT_XL);
    LAS float* PART = (LAS float*)(F.lds + RT_PART); LAS float* LOG = (LAS float*)(F.lds + RT_LOG);
    LAS int* lcnt = (LAS int*)(F.lds + RT_SMALL);
    LAS int* lbase = lcnt + 32;
    LAS int* sel_e = lcnt + 64;
    LAS int* sel_r = sel_e + 256;
    LAS float* sel_g = (LAS float*)(sel_r + 256);
    LAS float* topv = sel_g + 256;
    LAS int* topi = (LAS int*)(topv + 128);
    const int e_l = lane & 31, hi = lane >> 5;
    f32x4 gv[4], bv[4];
#pragma unroll
    for (int j = 0; j < 4; ++j) { gv[j] = *(const f32x4*)(g + 256 * j + 4 * lane); bv[j] = *(const f32x4*)(bb + 256 * j + 4 * lane); }
    const float rbc = rb[tid & 31];
    for (int chunk = (F.xok ? 32 * (F.bid & 7) + (F.bid >> 3) : F.bid); chunk < M / 64; chunk += F.G) {
        if (F.xok) pg8::flow_wait_wg(ctl + CW_RDY + 2048 + 64 * layer + (chunk >> 2), 4, wave);
        if (tid < 32) lcnt[tid] = 0;
        u32x2 yw[2][4][4];
#pragma unroll
        for (int rr = 0; rr < 4; ++rr)
#pragma unroll
            for (int j = 0; j < 4; ++j) { yw[0][rr][j] = *(const u32x2*)(ypre + ((size_t)chunk * 64 + wave * 4 + rr) * D + 256 * j + 4 * lane);
                yw[1][rr][j] = *(const u32x2*)(ypre + ((size_t)chunk * 64 + 32 + wave * 4 + rr) * D + 256 * j + 4 * lane); }
#pragma unroll
        for (int grp = 0; grp < 2; ++grp) {
            __syncthreads();
            bf16x8 bhf[8], blf[8];
#pragma unroll
            for (int ks = 0; ks < 8; ++ks) { const int s = wave * 8 + ks; bhf[ks] = *(const bf16x8*)(rwh + ((size_t)s * 64 + lane) * 8); blf[ks] = *(const bf16x8*)(rwl + ((size_t)s * 64 + lane) * 8); }
#pragma unroll
            for (int rr = 0; rr < 4; ++rr) {
                const int rl = wave * 4 + rr; const size_t row = (size_t)chunk * 64 + grp * 32 + rl;
                f32x4 v[4]; float s = 0.f;
#pragma unroll
                for (int j = 0; j < 4; ++j) { const u32x2 w = yw[grp][rr][j];
                    v[j] = (f32x4){__uint_as_float(w.x << 16), __uint_as_float(w.x & 0xffff0000u), __uint_as_float(w.y << 16), __uint_as_float(w.y & 0xffff0000u)}; s += (v[j][0] + v[j][1]) + (v[j][2] + v[j][3]); }
                const float mu = wave_sum(s) * (1.f / D); float q = 0.f;
#pragma unroll
                for (int j = 0; j < 4; ++j) { v[j] = v[j] - mu; q += (v[j][0] * v[j][0] + v[j][1] * v[j][1]) + (v[j][2] * v[j][2] + v[j][3] * v[j][3]); }
                const float rstd = rsqrtf(wave_sum(q) * (1.f / D) + LN_EPS);
#pragma unroll
                for (int j = 0; j < 4; ++j) { v[j] = v[j] * rstd * gv[j] + bv[j];
                    *(unsigned*)(x1f8 + row * D + 256 * j + 4 * lane) = pk4_fp8(v[j][0], v[j][1], v[j][2], v[j][3]);
                    u32x2 wh, wl; wh.x = cvt_pk_bf16(v[j][0], v[j][1]); wh.y = cvt_pk_bf16(v[j][2], v[j][3]);
                    wl.x = cvt_pk_bf16(v[j][0] - __uint_as_float(wh.x << 16), v[j][1] - __uint_as_float(wh.x & 0xffff0000u)); wl.y = cvt_pk_bf16(v[j][2] - __uint_as_float(wh.y << 16), v[j][3] - __uint_as_float(wh.y & 0xffff0000u));
                    *(LAS u32x2*)(XH + rl * RT_RS + 256 * j + 4 * lane) = wh; *(LAS u32x2*)(XL + rl * RT_RS + 256 * j + 4 * lane) = wl; }
            }
            __syncthreads();
            f32x16 acc = {};
#pragma unroll
            for (int ks = 0; ks < 8; ++ks) { const int s = wave * 8 + ks;
                const bf16x8 ah = *(const LAS bf16x8*)(XH + e_l * RT_RS + 16 * s + 8 * hi), al = *(const LAS bf16x8*)(XL + e_l * RT_RS + 16 * s + 8 * hi);
                const bf16x8 bh = bhf[ks], bl = blf[ks];
                acc = __builtin_amdgcn_mfma_f32_32x32x16_bf16(ah, bh, acc, 0, 0, 0); acc = __builtin_amdgcn_mfma_f32_32x32x16_bf16(al, bh, acc, 0, 0, 0); acc = __builtin_amdgcn_mfma_f32_32x32x16_bf16(ah, bl, acc, 0, 0, 0); }
            __syncthreads();
#pragma unroll
            for (int gq = 0; gq < 16; ++gq) PART[(wave * 32 + crow(gq, hi)) * 32 + e_l] = acc[gq];
            __syncthreads();
#pragma unroll
            for (int k = 0; k < 2; ++k) { const int idx = tid + 512 * k; float sm = 0.f;
#pragma unroll
                for (int w = 0; w < 8; ++w) sm += PART[w * 1024 + idx];
                LOG[idx] = sm + rbc; }
            __syncthreads();
            int l2 = lane; asm volatile("" : "+v"(l2)); const int e_l = l2 & 31, hi = l2 >> 5;
            for (int pr = 0; pr < 2; ++pr) {
                const int rl = wave * 4 + pr * 2 + hi; const LAS float* lrow = LOG + rl * 32;
                const float mine = lrow[e_l]; int rank = 0;
#pragma unroll
                for (int i = 0; i < 8; ++i) { const f32x4 o = *(const LAS f32x4*)(lrow + 4 * i);
#pragma unroll
                    for (int c = 0; c < 4; ++c) rank += (o[c] > mine || (o[c] == mine && 4 * i + c < e_l)) ? 1 : 0; }
                if (rank < 4) { topv[rl * 4 + rank] = mine; topi[rl * 4 + rank] = e_l; }
                if (e_l < 4) {
                    const f32x4 sv = *(const LAS f32x4*)(topv + rl * 4);
                    const float e1 = __expf(sv[1] - sv[0]), e2 = __expf(sv[2] - sv[0]), e3 = __expf(sv[3] - sv[0]);
                    const float inv = 1.f / (((1.f + e1) + e2) + e3);
                    const int ek = topi[rl * 4 + e_l];
                    const float gk = (e_l == 0 ? 1.f : e_l == 1 ? e1 : e_l == 2 ? e2 : e3) * inv;
                    const int lr = __hip_atomic_fetch_add(lcnt + ek, 1, __ATOMIC_RELAXED, __HIP_MEMORY_SCOPE_WORKGROUP);
                    const int idx = (grp * 32 + rl) * 4 + e_l; sel_e[idx] = ek; sel_g[idx] = gk; sel_r[idx] = lr;
                }
            }
        }
        __syncthreads();
        { int t2 = tid; asm volatile("" : "+v"(t2));
          if (t2 < 32) lbase[t2] = (int)__hip_atomic_fetch_add(cnt + 64 * t2, (unsigned)lcnt[t2], __ATOMIC_RELAXED, __HIP_MEMORY_SCOPE_AGENT);
          __syncthreads();
          if (t2 < 256) { const int e = sel_e[t2]; const int pos = lbase[e] + sel_r[t2];
              rowtok[e * CAP + pos] = (chunk * 64 + (t2 >> 2)) * 4 + (t2 & 3); rowgate[e * CAP + pos] = sel_g[t2]; } }
        __syncthreads();
    }
}

__device__ __forceinline__ void p_combine(Frame& F, int layer) {
    PHASE_PROLOGUE();
    const bf16* ypre = WSP(bf16, WS_YPRE); const bf16* ys = WSP(bf16, WS_YSLOT);
    const float* g = P->in[layer ? 28 : 16]; const float* bb = P->in[layer ? 29 : 17]; const float* g1 = P->in[layer ? 20 : 8]; const float* b1 = P->in[layer ? 21 : 9];
    float* xo = P->out; bf16* xob = WSP(bf16, WS_X2B);
    const int gw = F.bid * NWAVES + wave, NGW = F.G * NWAVES;
    f32x4 gv[4], bv[4];
#pragma unroll
    for (int j = 0; j < 4; ++j) { gv[j] = *(const f32x4*)(g + 256 * j + 4 * lane); bv[j] = *(const f32x4*)(bb + 256 * j + 4 * lane); }
    f32x4 g1v[4], b1v[4];
#pragma unroll
    for (int j = 0; j < 4; ++j) { g1v[j] = *(const f32x4*)(g1 + 256 * j + 4 * lane); b1v[j] = *(const f32x4*)(b1 + 256 * j + 4 * lane); }
    static_assert(YS8, "the prefetching combine reads fp8 slots");
    u32x2 pyw[4]; int psw[4][4];
#pragma unroll
    for (int j = 0; j < 4; ++j) { pyw[j] = *(const u32x2*)(ypre + (size_t)gw * D + 256 * j + 4 * lane);
#pragma unroll
        for (int k = 0; k < 4; ++k) psw[j][k] = *(const int*)((const unsigned char*)ys + ((size_t)gw * 4 + k) * D + 256 * j + 4 * lane); }
    for (int row = gw; row < M; row += NGW) {
        f32x4 v[4]; float s = 0.f;
        u32x2 cyw[4]; int csw[4][4];
#pragma unroll
        for (int j = 0; j < 4; ++j) { cyw[j] = pyw[j];
#pragma unroll
            for (int k = 0; k < 4; ++k) csw[j][k] = psw[j][k]; }
        if (row + NGW < M) { const size_t nr = (size_t)row + NGW;
#pragma unroll
            for (int j = 0; j < 4; ++j) { pyw[j] = *(const u32x2*)(ypre + nr * D + 256 * j + 4 * lane);
#pragma unroll
                for (int k = 0; k < 4; ++k) psw[j][k] = *(const int*)((const unsigned char*)ys + (nr * 4 + k) * D + 256 * j + 4 * lane); } }
        { float s1 = 0.f;
#pragma unroll
          for (int j = 0; j < 4; ++j) { const u32x2 w = cyw[j];
              v[j] = (f32x4){__uint_as_float(w.x << 16), __uint_as_float(w.x & 0xffff0000u), __uint_as_float(w.y << 16), __uint_as_float(w.y & 0xffff0000u)}; s1 += (v[j][0] + v[j][1]) + (v[j][2] + v[j][3]); }
          const float mu1 = wave_sum(s1) * (1.f / D); float q1 = 0.f;
#pragma unroll
          for (int j = 0; j < 4; ++j) { v[j] = v[j] - mu1; q1 += (v[j][0] * v[j][0] + v[j][1] * v[j][1]) + (v[j][2] * v[j][2] + v[j][3] * v[j][3]); }
          const float rstd1 = rsqrtf(wave_sum(q1) * (1.f / D) + LN_EPS);
#pragma unroll
          for (int j = 0; j < 4; ++j) v[j] = (v[j] * rstd1 * g1v[j] + b1v[j]) * ALPHA; }
#pragma unroll
        for (int j = 0; j < 4; ++j) {
#pragma unroll
            for (int k = 0; k < 4; ++k) {
                if constexpr (YS8) { const int w = csw[j][k]; const float iy = 1.f / (float)(1 << SH_Y);
                    const f32x2 lo = __builtin_amdgcn_cvt_pk_f32_fp8(w, false), hi = __builtin_amdgcn_cvt_pk_f32_fp8(w, true);
                    v[j][0] += lo[0] * iy; v[j][1] += lo[1] * iy; v[j][2] += hi[0] * iy; v[j][3] += hi[1] * iy; }
                else { const u32x2 w = *(const u32x2*)(ys + ((size_t)row * 4 + k) * D + 256 * j + 4 * lane);
                    v[j][0] += __uint_as_float(w.x << 16); v[j][1] += __uint_as_float(w.x & 0xffff0000u); v[j][2] += __uint_as_float(w.y << 16); v[j][3] += __uint_as_float(w.y & 0xffff0000u); } }
            s += (v[j][0] + v[j][1]) + (v[j][2] + v[j][3]); }
        const float mu = wave_sum(s) * (1.f / D); float q = 0.f;
#pragma unroll
        for (int j = 0; j < 4; ++j) { v[j] = v[j] - mu; q += (v[j][0] * v[j][0] + v[j][1] * v[j][1]) + (v[j][2] * v[j][2] + v[j][3] * v[j][3]); }
        const float rstd = rsqrtf(wave_sum(q) * (1.f / D) + LN_EPS);
#pragma unroll
        for (int j = 0; j < 4; ++j) { v[j] = v[j] * rstd * gv[j] + bv[j];
            if (layer) *(f32x4*)(xo + (size_t)row * D + 256 * j + 4 * lane) = v[j];
            else { u32x2 w; w.x = cvt_pk_bf16(v[j][0], v[j][1]); w.y = cvt_pk_bf16(v[j][2], v[j][3]); *(u32x2*)(xob + (size_t)row * D + 256 * j + 4 * lane) = w; } }
    }
}
__device__ __forceinline__ void p_attn(Frame& F) {
    PHASE_PROLOGUE();
    const bf16* Q = WSP(bf16, WS_QK1); const bf16* Kt = Q + (size_t)M * D; const bf16* VT = WSP(bf16, WS_VT1); bf16* AO = WSP(bf16, WS_AO);
    const int r = lane & 31, hh = lane >> 5;
    const int pir = (r & 0x13) | ((r & 4) << 1) | ((r & 8) >> 1);
    for (int wu = F.bid * NWAVES + wave; wu < BATCH * 8 * (SEQ / 32); wu += F.G * NWAVES) {
        const int qb = wu & 127, bhd = wu >> 7, b = bhd >> 3, hd = bhd & 7;
        const size_t tok0 = (size_t)b * SEQ; const int q0 = 32 * qb;
        bf16x8 qf[8];
#pragma unroll
        for (int s = 0; s < 8; ++s) qf[s] = *(const bf16x8*)(Q + (tok0 + q0 + r) * D + hd * 128 + 16 * s + 8 * hh);
        f32x16 o[4];
#pragma unroll
        for (int et = 0; et < 4; ++et) o[et] = (f32x16){};
        float carry = 1.f;
        bf16x8 kf[8];
        { const bf16* kp = Kt + ((size_t)bhd * SEQ + q0) * 128 + lane * 8;
#pragma unroll
          for (int s = 0; s < 8; ++s) kf[s] = *(const bf16x8*)(kp + 512 * s); }
        for (int kb = qb; kb >= 0; --kb) {
            const int k0 = 32 * kb;
            f32x16 st = {};
#pragma unroll
            for (int s = 0; s < 8; ++s) st = __builtin_amdgcn_mfma_f32_32x32x16_bf16(kf[s], qf[s], st, 0, 0, 0);
            if (kb > 0) { const bf16* kp = Kt + ((size_t)bhd * SEQ + k0 - 32) * 128 + lane * 8;
#pragma unroll
                for (int s = 0; s < 8; ++s) kf[s] = *(const bf16x8*)(kp + 512 * s); }
            float bt[16], omb[16];
#pragma unroll
            for (int g = 0; g < 16; ++g) { const float z = __builtin_amdgcn_fmed3f(st[g], -80.f, 80.f); const float ez = __builtin_amdgcn_exp2f(-z); bt[g] = __builtin_amdgcn_rcpf(1.f + ez); omb[g] = ez * bt[g]; }
            if (kb == qb) {
#pragma unroll
                for (int g = 0; g < 16; ++g) { const int kl = 16 * (g >> 3) + 8 * hh + (g & 7); if (kl >= r) { bt[g] = 0.f; omb[g] = 1.f; } } }
            float rA = omb[0], rB = omb[8];
#pragma unroll
            for (int g = 1; g < 8; ++g) { rA *= omb[g]; rB *= omb[g + 8]; }
            const float pA = __shfl_xor(rA, 32), pB = __shfl_xor(rB, 32);
            float a[16];
            float run = carry * (hh ? 1.f : pB);
#pragma unroll
            for (int g = 15; g >= 8; --g) { a[g] = bt[g] * run; run *= omb[g]; }
            run = carry * (rB * pB) * (hh ? 1.f : pA);
#pragma unroll
            for (int g = 7; g >= 0; --g) { a[g] = bt[g] * run; run *= omb[g]; }
            carry *= (rA * rB) * (pA * pB);
#pragma unroll
            for (int s = 0; s < 2; ++s) {
                u32x4 pw; pw.x = cvt_pk_bf16(a[8 * s + 0], a[8 * s + 1]); pw.y = cvt_pk_bf16(a[8 * s + 2], a[8 * s + 3]); pw.z = cvt_pk_bf16(a[8 * s + 4], a[8 * s + 5]); pw.w = cvt_pk_bf16(a[8 * s + 6], a[8 * s + 7]);
#pragma unroll
                for (int et = 0; et < 4; ++et) { const bf16x8 vf = *(const bf16x8*)(VT + ((size_t)bhd * SEQ + k0) * 128 + ((s * 4 + et) * 64 + lane) * 8);
                    o[et] = __builtin_amdgcn_mfma_f32_32x32x16_bf16(__builtin_bit_cast(bf16x8, pw), vf, o[et], 0, 0, 0); }
            }
            if (__all(carry < SB_EXIT)) break;
        }
#pragma unroll
        for (int et = 0; et < 4; ++et)
#pragma unroll
            for (int g = 0; g < 16; ++g) ((unsigned char*)AO)[(tok0 + q0 + crow(g, hh)) * D + hd * 128 + 32 * et + r] = fp8_1(o[et][g] * (float)(1 << SH_MIX));
    }
}

#ifndef MOE_ALIGN_EPI
#define MOE_ALIGN_EPI 1
#endif
constexpr bool MOE_ALIGN = MOE_ALIGN_EPI != 0;
constexpr int AUX_T2E = AUX_OFF, AUX_TSTART = AUX_OFF + 1280, AUX_TAB = AUX_OFF + 1536, AUX_BIAS = AUX_OFF + 1536 + 10240;
static_assert(AUX_BIAS + 3072 <= AUX_OFF + AUX_BYTES, "AUX map");
__device__ __forceinline__ int build_tiles(Frame& F, const unsigned* cnt) {
    PHASE_PROLOGUE();
    LAS int* t2e = (LAS int*)(F.lds + AUX_T2E); LAS int* ts = (LAS int*)(F.lds + AUX_TSTART);
    if (tid < NE) t2e[288 + tid] = (int)cnt[64 * tid];
    __syncthreads();
    if (tid == 0) { int T = 0;
        for (int e = 0; e < NE; ++e) { ts[e] = T; const int n = (t2e[288 + e] + 255) >> 8; for (int i = 0; i < n; ++i) t2e[T + i] = e; T += n; }
        ts[NE] = T; }
    __syncthreads();
    return ts[NE];
}

#ifdef ONLY_PHASE
#define IN(k) ((k) == ONLY_PHASE)
#else
#define IN(k) (lo <= (k) && (k) < hi)
#endif
#define SEAM(k) do { if (IN(k) && IN((k) + 1)) xcd_barrier(bar); } while (0)
template <int layer>
__device__ __forceinline__ void layer_phases(Frame& F, const XcdBarrier& bar, const int lo, const int hi) {
    LAS unsigned char* ring = F.lds + RING_OFF;
    {
        constexpr int pb = layer ? 12 : 5;
        if constexpr (layer == 1) {
            if (IN(10)) { PHASE_PROLOGUE();
                { pg8::Gemm g{WSP(bf16, WS_X2B), WSP(bf16, WS_WIN1), M, 2 * D, D, 0, 0};
                  pg8::StaticOrder S; S.init(M / 256, 2 * D / 256, F.G, F.bid, nullptr);
                  pg8::EpiQK E{WSP(bf16, WS_QK1), WSP(bf16, WS_QK1) + (size_t)M * D, QSCALE1};
                  pg8::gemm_phase<pg8::EpiQK, false, true>(ring, g, S, E, nullptr, F.wave); }
                { pg8::Gemm g{WSP(bf16, WS_WIN1) + (size_t)2 * D * D, WSP(bf16, WS_X2B), D, M, D, 0, 0};
                  pg8::StaticOrder S; S.init(D / 256, M / 256, F.G, F.bid, nullptr);
                  pg8::EpiVT E{WSP(bf16, WS_VT1)};
                  pg8::gemm_phase<pg8::EpiVT, false, true>(ring, g, S, E, nullptr, F.wave); }
            } SEAM(10);
            if (IN(11)) { p_attn(F);
            } SEAM(11);
        }
        if (IN(pb)) { PHASE_PROLOGUE();
            pg8::Gemm g{layer ? WSP(bf16, WS_AO) : WSP(bf16, WS_MIX), WSP(bf16, layer ? WS_WOUT1 : WS_WOUT0), M, D, D, 0, SCL_OUT, ctl + CW_RDY + 2048 + 64 * layer};
            pg8::StaticOrder S; S.init(M / 256, D / 256, F.G, F.bid, nullptr);
            pg8::EpiResid<true> E{layer ? (const void*)WSP(bf16, WS_X2B) : (const void*)WSP(bf16, WS_XBF), WSP(bf16, WS_YPRE)};
            pg8::gemm_phase<pg8::EpiResid<true>, false, true, true, pg8::NoRide, pg8::StaticOrder, 1>(ring, g, S, E, nullptr, F.wave);
        }
        if (IN(pb) && IN(pb + 1) && !F.xok) xcd_barrier(bar);
        if (IN(pb + 1)) { p_router(F, layer); } SEAM(pb + 1);
        if (IN(pb + 2)) { PHASE_PROLOGUE(); const unsigned* cnt = ctl + CW_CNT + layer * 2048;
            const int T = build_tiles(F, cnt);
            const LAS int* t2e = (const LAS int*)(F.lds + AUX_T2E); const LAS int* ts = (const LAS int*)(F.lds + AUX_TSTART);
            LAS int* rowtab = (LAS int*)(F.lds + AUX_TAB);
            pg8::XcdOrder S; S.init(T, 2 * FF / 256, F.G, F.bid, 0, t2e);
            const int* rowtok = WSP(int, WS_ROWTOK);
            { const int nu = S.count();
#pragma unroll 5
              for (int en = tid; en < nu * 256; en += 512) { pg8::Unit u; S.next(en >> 8, u); const int idx = (u.pm - ts[u.e]) * 256 + (en & 255); const bool ok = idx < t2e[288 + u.e];
                  rowtab[en] = rowtok[u.e * CAP + (ok ? idx : 0)] >> 2; } }
            __syncthreads();
            constexpr bool F8 = MOE_FP8[layer];
            pg8::Gemm g{F8 ? WSP(void, WS_X1F8) : WSP(void, WS_X1B), WSP(bf16, layer ? WS_WUP1 : WS_WUP0), T * 256, 2 * FF, D, (size_t)2 * FF * D * (F8 ? 1 : 2), SCL_UP, ctl + CW_RDY + 512 * layer};
            pg8::EpiUp<F8> E{P->in[layer ? 25 : 13], WSP(void, WS_ACT), (LAS float*)(F.lds + AUX_BIAS)};
            if constexpr (layer == 0) { MoeRide R; R.P = P; R.ws = ws; R.base = MOE_ITEMS_L; R.limit = MOE_ITEMS; R.ok = false;
                pg8::gemm_phase<pg8::EpiUp<F8>, true, MOE_ALIGN, F8, MoeRide, pg8::XcdOrder, 1>(ring, g, S, E, rowtab, F.wave, R); }
            else pg8::gemm_phase<pg8::EpiUp<F8>, true, MOE_ALIGN, F8, pg8::NoRide, pg8::XcdOrder, 1>(ring, g, S, E, rowtab, F.wave);
        }
        if (IN(pb + 2) && IN(pb + 3) && !F.xok) xcd_barrier(bar);
        if (IN(pb + 3)) { PHASE_PROLOGUE(); const unsigned* cnt = ctl + CW_CNT + layer * 2048;
            int T; if (IN(pb + 2)) { __syncthreads(); T = ((const LAS int*)(F.lds + AUX_TSTART))[NE]; } else T = build_tiles(F, cnt);
            const LAS int* t2e = (const LAS int*)(F.lds + AUX_T2E); const LAS int* ts = (const LAS int*)(F.lds + AUX_TSTART);
            LAS int* ttok = (LAS int*)(F.lds + AUX_TAB); LAS float* tgate = (LAS float*)(F.lds + AUX_TAB + 5 * 1024);
            pg8::XcdOrder S; S.init(T, D / 256, F.G, F.bid, 2 * FF / 256, t2e);
            const int* rowtok = WSP(int, WS_ROWTOK); const float* rowgate = WSP(float, WS_ROWGATE);
            { const int nu = S.count();
#pragma unroll 3
              for (int en = tid; en < nu * 256; en += 512) { pg8::Unit u; S.next(en >> 8, u); const int idx = (u.pm - ts[u.e]) * 256 + (en & 255); const bool ok = idx < t2e[288 + u.e];
                  ttok[en] = ok ? rowtok[u.e * CAP + idx] : -1; tgate[en] = ok ? rowgate[u.e * CAP + idx] : 0.f; } }
            __syncthreads();
            constexpr bool F8 = MOE_FP8[layer];
            pg8::Gemm g{WSP(bf16, WS_ACT), WSP(bf16, layer ? WS_WDN1 : WS_WDN0), T * 256, D, FF, (size_t)D * FF * (F8 ? 1 : 2), SCL_DN, ctl + CW_RDY + 512 * layer};
            pg8::EpiDown E{P->in[layer ? 27 : 15], WSP(bf16, WS_YSLOT), ttok, tgate, (LAS float*)(F.lds + AUX_BIAS)};
            if constexpr (layer == 0) { MoeRide R; R.P = P; R.ws = ws; R.base = MOE_ITEMS_L + T * 64; R.limit = MOE_ITEMS; R.ok = false;
                pg8::gemm_phase<pg8::EpiDown, false, MOE_ALIGN, F8, MoeRide, pg8::XcdOrder, 2, 2 * FF / 256>(ring, g, S, E, nullptr, F.wave, R); }
            else pg8::gemm_phase<pg8::EpiDown, false, MOE_ALIGN, F8, pg8::NoRide, pg8::XcdOrder, 2, 2 * FF / 256>(ring, g, S, E, nullptr, F.wave);
        } SEAM(pb + 3);
        if (IN(pb + 4)) { p_combine(F, layer); }
        if constexpr (layer == 0) SEAM(pb + 4);
    }
}
#undef IN
#undef SEAM
__global__ void __launch_bounds__(NWAVES * 64, 2) mega(Params Pk) {
    extern __shared__ __attribute__((aligned(16))) unsigned char lds_raw[];
    Frame F; F.lds = (LAS unsigned char*)lds_raw; F.G = gridDim.x; F.bid = blockIdx.x; F.wave = __builtin_amdgcn_readfirstlane(threadIdx.x >> 6); F.xok = 0;
    volatile LAS unsigned* MISC = (volatile LAS unsigned*)(F.lds + LCTL_OFF);
    if (threadIdx.x < 256) MISC[threadIdx.x] = 0u;
    __syncthreads();
    XcdBarrier bar = xcd_barrier_post((unsigned*)(Pk.ws + WS_CTL) + CW_BAR + Pk.li * XCD_BAR_WORDS, MISC + 8);
    const int lo = Pk.ph_lo, hi = Pk.ph_hi;
#ifdef ONLY_PHASE
#define IN(k) ((k) == ONLY_PHASE)
#else
#define IN(k) (lo <= (k) && (k) < hi)
#endif
#define SEAM(k) do { if (IN(k) && IN((k) + 1)) xcd_barrier(bar); } while (0)
    LAS unsigned char* ring = F.lds + RING_OFF;

    if (IN(0)) { p0_prep(F); } SEAM(0);
    if (IN(0) && IN(1)) { const unsigned* barw = (const unsigned*)(Pk.ws + WS_CTL) + CW_BAR + Pk.li * XCD_BAR_WORDS; bool even = true;
        for (int j = 0; j < 16; ++j) { const unsigned c = __builtin_nontemporal_load(barw + XB_XCNT(j)); even = even && (c == (j < 8 ? (unsigned)F.G / 8u : 0u)); }
        if (even && (F.G & 7) == 0) { F.bid = (int)(MISC[10] * 8u + MISC[11]); F.xok = 1; } }

    if (IN(1)) { PHASE_PROLOGUE();
        pg8::Gemm g{WSP(bf16, WS_XBF), WSP(bf16, WS_WIN0), M, L0N, D, 0, 0};
        pg8::StaticOrder S; S.init(M / 256, L0N / 256, F.G, F.bid, nullptr);
        pg8::EpiInProj0 E{WSP(bf16, WS_Q0), WSP(bf16, WS_K0), WSP(bf16, WS_V0), WSP(bf16, WS_SG), WSP(bf16, WS_U), WSP(float, WS_ROPE)};
        pg8::gemm_phase<pg8::EpiInProj0, false, true>(ring, g, S, E, nullptr, F.wave);
        if (F.bid >= 128) moe_convert(F, CONV_A0 + CONV_P2 + (F.bid - 128) * CONV_C1 + F.wave, CONV_C1 / 8, 8, MOE_ITEMS_L);
    } SEAM(1);

    if (IN(2)) { for (int u = F.bid; u < 256 + 1024; u += F.G) { if (u < 256) p2_conv_unit(F, u); else p2_kv_unit(F, u - 256, CONV_A0 + (u - 256) * 8 + F.wave); } } SEAM(2);
    if (IN(3)) { p2_scan(F); } SEAM(3);
    if (IN(4)) { for (int wu = F.bid * NWAVES + F.wave; wu < 2048; wu += F.G * NWAVES) p2_ret_wave(F, wu); } SEAM(4);

    layer_phases<0>(F, bar, lo, hi);
    layer_phases<1>(F, bar, lo, hi);
#undef IN
#undef SEAM
}
static void launch_mega(const Params& base, int lo, int hi, int li, int grid, hipStream_t stream) {
    Params p = base; p.ph_lo = lo; p.ph_hi = hi; p.li = li; p.pad = 0;
    hipLaunchKernelGGL(mega, dim3(grid), dim3(NWAVES * 64), LDS_BYTES, stream, p);
}
extern "C" void kernel_launch(void* const* d_in, const int* in_sizes, int n_in, void* d_out, int out_size, void* d_ws, size_t ws_size, hipStream_t stream) {
    static int grid = 0;
    if (grid == 0) {
        if (n_in != 30 || ws_size < WS_END || out_size != M * D) { fprintf(stderr, "kernel_launch: unexpected shapes n_in=%d ws=%zu out=%d\n", n_in, ws_size, out_size); grid = -1; return; }
        int dev = 0, cus = 0, per_cu = 0;
        if (hipGetDevice(&dev) != hipSuccess || hipDeviceGetAttribute(&cus, hipDeviceAttributeMultiprocessorCount, dev) != hipSuccess) { grid = -1; return; }
        if (hipFuncSetAttribute((const void*)mega, hipFuncAttributeMaxDynamicSharedMemorySize, LDS_BYTES) != hipSuccess) { fprintf(stderr, "kernel_launch: hipFuncSetAttribute failed\n"); grid = -1; return; }
        if (hipOccupancyMaxActiveBlocksPerMultiprocessor(&per_cu, (const void*)mega, NWAVES * 64, LDS_BYTES) != hipSuccess || per_cu < 1) { fprintf(stderr, "kernel_launch: occupancy query says %d\n", per_cu); (void)hipGetLastError(); grid = -1; return; }
        grid = cus;
        if (grid != 256) { fprintf(stderr, "kernel_launch: built for 256 CUs, device has %d\n", cus); grid = -1; return; }
    }
    if (grid < 0) return;
    (void)hipMemsetAsync((char*)d_ws + WS_CTL, 0, 1 * MiB, stream);
    Params a{};
    for (int i = 0; i < 30; ++i) a.in[i] = (const float*)d_in[i];
    a.out = (float*)d_out; a.ws = (unsigned char*)d_ws;
    launch_mega(a, 0, 17, 0, grid, stream);
}
```

```cpp
#include <hip/hip_runtime.h>
#include <cstdint>
#include <cstdio>

typedef unsigned short bf16;
#define LAS __attribute__((address_space(3)))
#define GAS __attribute__((address_space(1)))
typedef short bf16x8 __attribute__((ext_vector_type(8)));
typedef float f32x4 __attribute__((ext_vector_type(4)));
typedef float f32x2 __attribute__((ext_vector_type(2)));
typedef float f32x16 __attribute__((ext_vector_type(16)));
typedef unsigned u32x4 __attribute__((ext_vector_type(4)));
typedef unsigned u32x2 __attribute__((ext_vector_type(2)));
typedef int v4i __attribute__((ext_vector_type(4)));
typedef int v8i __attribute__((ext_vector_type(8)));

__device__ __forceinline__ float bf2f(bf16 v) { return __uint_as_float(((unsigned)v) << 16); }
__device__ __forceinline__ unsigned f2bf(float f) { unsigned u = __float_as_uint(f); return (u + 0x7fffu + ((u >> 16) & 1u)) >> 16; }
__device__ __forceinline__ unsigned pk2(float lo, float hi) { return f2bf(lo) | (f2bf(hi) << 16); }
typedef __bf16 bf16x2_t __attribute__((ext_vector_type(2)));
__device__ __forceinline__ unsigned cvt_pk_bf16(float lo, float hi) { const f32x2 v = {lo, hi}; const bf16x2_t b = __builtin_convertvector(v, bf16x2_t); return __builtin_bit_cast(unsigned, b); }
__device__ __forceinline__ float sigmoidf_(float x) { return __builtin_amdgcn_rcpf(1.f + __builtin_amdgcn_exp2f(-1.4426950408889634f * x)); }
template <int CTRL> __device__ __forceinline__ float dpp_mov(float v) { return __builtin_bit_cast(float, __builtin_amdgcn_update_dpp(0, __builtin_bit_cast(int, v), CTRL, 0xF, 0xF, true)); }
__device__ __forceinline__ float row16_sum(float v) { v += dpp_mov<0xB1>(v); v += dpp_mov<0x4E>(v); v += dpp_mov<0x141>(v); v += dpp_mov<0x140>(v); return v; }
__device__ __forceinline__ float lane_bcast(float v, int l) { return __builtin_bit_cast(float, __builtin_amdgcn_readlane(__builtin_bit_cast(int, v), l)); }
__device__ __forceinline__ float wave_sum(float v) { v = row16_sum(v); return (lane_bcast(v, 0) + lane_bcast(v, 16)) + (lane_bcast(v, 32) + lane_bcast(v, 48)); }
__device__ __forceinline__ float half32_sum(float v) { v = row16_sum(v); return v + __shfl_xor(v, 16); }

__device__ __forceinline__ unsigned pk4_fp8(float a, float b, float c, float d) {
    a = __builtin_amdgcn_fmed3f(a, -448.f, 448.f); b = __builtin_amdgcn_fmed3f(b, -448.f, 448.f); c = __builtin_amdgcn_fmed3f(c, -448.f, 448.f); d = __builtin_amdgcn_fmed3f(d, -448.f, 448.f);
    int w = 0; w = __builtin_amdgcn_cvt_pk_fp8_f32(a, b, w, false); w = __builtin_amdgcn_cvt_pk_fp8_f32(c, d, w, true); return (unsigned)w; }
__device__ __forceinline__ unsigned pk4_fp8_inrange(float a, float b, float c, float d) {
    int w = 0; w = __builtin_amdgcn_cvt_pk_fp8_f32(a, b, w, false); w = __builtin_amdgcn_cvt_pk_fp8_f32(c, d, w, true); return (unsigned)w; }
__device__ __forceinline__ f32x4 swiglu4(const f32x4 g, const f32x4 l, const float s) {
    f32x4 a, e, r, b;
#pragma unroll
    for (int j = 0; j < 4; ++j) { a[j] = __builtin_amdgcn_fmed3f(g[j], -3.0e38f, 7.f); b[j] = __builtin_amdgcn_fmed3f(l[j], -7.f, 7.f); }
    const f32x4 x = a * (-1.702f * 1.4426950408889634f);
#pragma unroll
    for (int j = 0; j < 4; ++j) e[j] = __builtin_amdgcn_exp2f(x[j]);
    const f32x4 d = e + 1.f;
#pragma unroll
    for (int j = 0; j < 4; ++j) r[j] = __builtin_amdgcn_rcpf(d[j]);
    const f32x4 t = b * s + s;
    return (a * r) * t;
}
#ifndef MOE_FP8_L0
#define MOE_FP8_L0 1
#endif
#ifndef MOE_FP8_L1
#define MOE_FP8_L1 1
#endif
constexpr bool MOE_FP8[2] = {MOE_FP8_L0 != 0, MOE_FP8_L1 != 0};
#ifndef YSLOT_FP8
#define YSLOT_FP8 1
#endif
constexpr bool YS8 = YSLOT_FP8 != 0; constexpr int SH_Y = 4;
constexpr int SH_WUP = 6, SH_WDN = 6, SH_ACT = 2;
constexpr int SCL_UP = 0x01010101 * (127 - SH_WUP / 2), SCL_DN = 0x01010101 * (127 - (SH_WDN + SH_ACT) / 2);
static_assert(SH_WUP % 2 == 0 && (SH_WDN + SH_ACT) % 2 == 0, "even total shifts");
constexpr int SH_WOUT = 6, SH_MIX = 4; constexpr int SCL_OUT = 0x01010101 * (127 - (SH_WOUT + SH_MIX) / 2);
static_assert((SH_WOUT + SH_MIX) % 2 == 0, "even total shift");
__device__ __forceinline__ unsigned char fp8_1(float a) { a = __builtin_amdgcn_fmed3f(a, -448.f, 448.f); return (unsigned char)(__builtin_amdgcn_cvt_pk_fp8_f32(a, a, 0, false) & 0xff); }
constexpr int D = 1024, BATCH = 4, SEQ = 4096, M = BATCH * SEQ;
constexpr int L0N = 2560, NE = 32, FF = 1024, CAP = 16384;
constexpr float LN_EPS = 1e-5f;
constexpr float ALPHA = 1.4142135623730951f;
constexpr float QSCALE1 = 0.08838834764831845f * 1.4426950408889634f;
constexpr float LN2F = 0.6931471805599453f;
constexpr float SB_EXIT = 7.174648e-43f;

constexpr size_t MiB = 1ull << 20;
constexpr size_t WS_CTL = 0;
constexpr size_t WS_WIN0 = 1 * MiB, WS_WOUT0 = 6 * MiB, WS_WIN1 = 8 * MiB, WS_WOUT1 = 14 * MiB;
constexpr size_t WS_WUP0 = 16 * MiB, WS_WUP1 = 144 * MiB, WS_WDN0 = 272 * MiB, WS_WDN1 = 336 * MiB;
constexpr size_t WS_ROPE = 400 * MiB;
constexpr size_t WS_RWT = 401 * MiB;
constexpr size_t WS_X1F8 = 402 * MiB;
constexpr size_t WS_X1 = 402 * MiB, WS_X1B = 466 * MiB, WS_X2 = 498 * MiB, WS_X2B = 562 * MiB, WS_YPRE = 594 * MiB;
constexpr size_t WS_ROWTOK = 658 * MiB, WS_ROWGATE = 660 * MiB;
constexpr size_t WS_S = 664 * MiB;
constexpr size_t WS_Q0 = WS_S, WS_K0 = WS_S + 8 * MiB, WS_V0 = WS_S + 16 * MiB, WS_SG = WS_S + 32 * MiB, WS_U = WS_S + 48 * MiB, WS_MIX = WS_S + 64 * MiB;
constexpr size_t WS_XBF = WS_S + 96 * MiB;
constexpr size_t WS_QK1 = WS_S, WS_VT1 = WS_S + 64 * MiB, WS_AO = WS_S + 96 * MiB;
constexpr size_t WS_ACT = WS_S;
constexpr size_t WS_YSLOT = 808 * MiB;
constexpr size_t WS_KV = 808 * MiB;
constexpr size_t WS_RT = 840 * MiB;
constexpr size_t WS_HBUF = 808 * MiB;
constexpr size_t WS_END = 1024 * MiB;
constexpr int CW_CNT = 1024, CW_BAR = 8192, CW_RDY = 131072;

namespace pg8 {
constexpr int BM = 256, BK = 64, HALF = 128, HTB = HALF * BK * 2, STAGE_BYTES = 8 * HTB, NXCD = 8, WGM = 8;
__host__ __device__ __forceinline__ int lds_byte(int r, int c) { const int st = (r >> 4) * 2 + (c >> 5), rr = r & 15, cc = c & 31, ob = rr * 64 + cc * 2; return st * 1024 + (ob ^ (((ob >> 9) & 1) << 5)); }
__host__ __device__ __forceinline__ void stage_rc(int b, int& R, int& C) { const int st = b / 1024, sb = b % 1024, swz = sb ^ (((sb >> 9) & 1) << 5); R = (st >> 1) * 16 + swz / 64; C = (st & 1) * 32 + (swz % 64) / 2; }
__host__ __device__ __forceinline__ int perm32(int rho) { const int n = rho >> 4, i = rho & 15; return 8 * (i >> 2) + 4 * n + (i & 3); }

struct Unit { int pm, pn, e; };
struct Gemm { const void* A; const void* Bt; int M, N, K; size_t estride; int scl; unsigned* rdy; };

struct StaticOrder {
    int nM, nN, nwg, G, c; const LAS int* t2e;
    __device__ void init(int nM_, int nN_, int G_, int c_, const LAS int* t2e_) { nM = nM_; nN = nN_; nwg = nM * nN; G = G_; c = c_; t2e = t2e_; }
    __device__ int count() const { return (nwg - c + G - 1) / G; }
    __device__ int ord(int i) const { return (int)((long)i * G + c); }
    __device__ bool next(int i, Unit& u) const {
        const long L = (long)i * G + c; if (L >= nwg) return false;
        int wgid = (int)L; { const int q = nwg / NXCD, r = nwg % NXCD, xcd = wgid % NXCD, off = wgid / NXCD; wgid = (xcd < r ? xcd * (q + 1) : r * (q + 1) + (xcd - r) * q) + off; }
        const int nig = WGM * nN, gid = wgid / nig, fm = gid * WGM, gsz = (nM - fm) < WGM ? (nM - fm) : WGM;
        u.pm = fm + ((wgid % nig) % gsz); u.pn = (wgid % nig) / gsz; u.e = t2e ? t2e[u.pm] : 0; return true;
    }
};

struct XcdOrder {
    int nN, T0, ntx, k, per, nloc; const LAS int* t2e;
    __device__ void init(int nM, int nN_, int G_, int c_, int prevN, const LAS int* t2e_) { nN = nN_; t2e = t2e_; per = G_ / NXCD;
        const int x = c_ % NXCD, q = nM / NXCD, r = nM % NXCD; ntx = q + (x < r ? 1 : 0); T0 = x * q + (x < r ? x : r); nloc = ntx * nN;
        k = (c_ / NXCD - (ntx * prevN) % per + per) % per; }
    __device__ int count() const { return nloc > k ? (nloc - k + per - 1) / per : 0; }
    __device__ int ord(int i) const { return T0 * nN + i * per + k; }
    __device__ bool next(int i, Unit& u) const { const int j = i * per + k; if (j >= nloc) return false;
        const int nig = WGM * nN, fm = (j / nig) * WGM, gsz = (ntx - fm) < WGM ? (ntx - fm) : WGM, w = j % nig;
        u.pm = T0 + fm + w % gsz; u.pn = w / gsz; u.e = t2e[u.pm]; return true; }
};
__device__ __forceinline__ unsigned flow_peek(const unsigned* w) { return (unsigned)__builtin_amdgcn_readfirstlane((int)__hip_atomic_load(w, __ATOMIC_RELAXED, __HIP_MEMORY_SCOPE_AGENT)); }
__device__ __forceinline__ void flow_wait(const unsigned* w, unsigned need) { while (flow_peek(w) < need) __builtin_amdgcn_s_sleep(4); }
__device__ __forceinline__ void flow_wait_wg(const unsigned* w, unsigned need, int wave) { if (wave == 0) { while (flow_peek(w) < need) __builtin_amdgcn_s_sleep(8); } __builtin_amdgcn_s_barrier(); }

__device__ __forceinline__ void mfma_f8(f32x4& acc, const v8i a, const v8i b, const int scl) {
    asm volatile("s_nop 1\n\tv_mfma_scale_f32_16x16x128_f8f6f4 %0, %1, %2, %0, %3, %3 op_sel_hi:[0,0,0]" : "+v"(acc) : "v"(a), "v"(b), "v"(scl));
}
template <class E, class = void> struct has_ldsbias { static constexpr bool v = false; };
template <class E> struct has_ldsbias<E, decltype((void)E::LDSBIAS)> { static constexpr bool v = E::LDSBIAS; };
template <class E, class = void> struct has_accbias { static constexpr bool v = false; };
template <class E> struct has_accbias<E, decltype((void)E::ACCBIAS)> { static constexpr bool v = E::ACCBIAS; };
struct NoRide { __device__ __forceinline__ void begin(int, int, int) {} __device__ __forceinline__ void end(int) {} };
template <class Epi, bool GATHER, bool ALIGN_EPI, bool FP8 = false, class Ride = NoRide, class Ord = StaticOrder, int FLOW = 0, int FLOW_NEED = 0>
__device__ __forceinline__ void gemm_phase(LAS unsigned char* lds, const Gemm g, const Ord& S, const Epi& E, const LAS int* rowtab, const int wave_id, Ride ride = Ride()) {
    int lane_ = (int)__builtin_amdgcn_mbcnt_hi(~0u, __builtin_amdgcn_mbcnt_lo(~0u, 0u)); asm volatile("" : "+v"(lane_));
    const int lane = lane_, wid = wave_id, tid = wid * 64 + lane, wr = wid >> 2, wc = wid & 3, fr = lane & 15, fq = lane >> 4;
    const int K = g.K, rowb = K * (FP8 ? 1 : 2), nt = rowb / 128;
    const size_t kstep = 128;
    const size_t hstep = (size_t)HALF * rowb;
    const size_t tstep = 2 * hstep;
    const int scl_w = g.scl; (void)scl_w;
    unsigned voffB[2], vc[2][2], vn[2][2];
#pragma unroll
    for (int i = 0; i < 2; ++i) { int R, C; stage_rc(tid * 16 + i * 8192, R, C); const int Rb = Epi::PERM ? ((R & ~31) + perm32(R & 31)) : R;
        voffB[i] = (unsigned)(Rb * rowb + C * 2);
        vc[0][i] = (unsigned)(R * rowb + C * 2); vc[1][i] = vc[0][i] + (unsigned)hstep; vn[0][i] = vc[0][i]; vn[1][i] = vc[1][i]; }
    const unsigned ldsw = (unsigned)wid * 1024u;
    const int aoff = lds_byte(wr * 64 + fr, fq * 8), boff = lds_byte(wc * 32 + fr, fq * 8);
#define PG8_SA(b, h) (((b) * 2 + (h)) * HTB)
#define PG8_SB(b, h) ((4 + (b) * 2 + (h)) * HTB)
#define PG8_STAGE(bufoff, gbase, voff) do { _Pragma("unroll") for (int _i = 0; _i < 2; ++_i) \
        __builtin_amdgcn_global_load_lds((const unsigned*)((const char*)(gbase) + (voff)[_i]), (LAS unsigned*)(lds + (bufoff) + ldsw + _i * 8192), 16, 0, 0); } while (0)
#define PG8_LDA(dst, b, h) do { _Pragma("unroll") for (int m = 0; m < 4; ++m) _Pragma("unroll") for (int k = 0; k < 2; ++k) dst[m][k] = *(const LAS bf16x8*)(lds + PG8_SA(b, h) + aoff + m * 2048 + k * 1024); } while (0)
#define PG8_LDB(dst, b, h) do { _Pragma("unroll") for (int n = 0; n < 2; ++n) _Pragma("unroll") for (int k = 0; k < 2; ++k) dst[n][k] = *(const LAS bf16x8*)(lds + PG8_SB(b, h) + boff + n * 2048 + k * 1024); } while (0)
#define PG8_CAT(x0, x1) __builtin_shufflevector(__builtin_bit_cast(v4i, x0), __builtin_bit_cast(v4i, x1), 0, 1, 2, 3, 4, 5, 6, 7)
#define PG8_MMA(ai, bj, At, Bt) do { __builtin_amdgcn_s_setprio(1); if constexpr (FP8) { _Pragma("unroll") for (int m = 0; m < 4; ++m) _Pragma("unroll") for (int n = 0; n < 2; ++n) \
        mfma_f8(acc[ai][bj][m][n], PG8_CAT(Bt[n][0], Bt[n][1]), PG8_CAT(At[m][0], At[m][1]), scl_w); } else { \
        _Pragma("unroll") for (int m = 0; m < 4; ++m) _Pragma("unroll") for (int n = 0; n < 2; ++n) _Pragma("unroll") for (int k = 0; k < 2; ++k) \
        acc[ai][bj][m][n] = __builtin_amdgcn_mfma_f32_16x16x32_bf16(Bt[n][k], At[m][k], acc[ai][bj][m][n], 0, 0, 0); } __builtin_amdgcn_s_setprio(0); } while (0)
#define PG8_WAIT_V(n) asm volatile("s_waitcnt vmcnt(" #n ")" ::: "memory")
#define PG8_WAIT_L(n) asm volatile("s_waitcnt lgkmcnt(" #n ")" ::: "memory")
#define PG8_BAR __builtin_amdgcn_s_barrier()
#define PG8_SCHED __builtin_amdgcn_sched_barrier(0)
#define PG8_ROWOFF(dst, slot) do { if constexpr (GATHER) { _Pragma("unroll") for (int _i = 0; _i < 2; ++_i) { int _R, _C; stage_rc(tid * 16 + _i * 8192, _R, _C); _Pragma("unroll") for (int _h = 0; _h < 2; ++_h) \
        dst[_h][_i] = (unsigned)rowtab[(slot) * 256 + _h * 128 + _R] * (unsigned)rowb + (unsigned)(_C * 2); } } } while (0)
    Unit cur, nxt; int ui = 0;
    if (!S.next(0, cur)) return;
    int pub_pm = -1; (void)pub_pm;
    if constexpr (FLOW == 2) { flow_wait(g.rdy + cur.pm, FLOW_NEED); if (S.next(1, nxt)) flow_wait(g.rdy + nxt.pm, FLOW_NEED); }
    if constexpr (has_ldsbias<Epi>::v) { if (wid < 4) __builtin_amdgcn_global_load_lds((const unsigned*)(E.bias(cur) + wid * 64 + lane), (LAS unsigned*)(E.bl + wid * 64), 4, 0, 0); }
    f32x4 acc[2][2][4][2];
    if constexpr (has_accbias<Epi>::v) { asm volatile("s_waitcnt vmcnt(0)" ::: "memory"); __builtin_amdgcn_s_barrier(); E.init(acc, 0, wc, fq); }
    else {
#pragma unroll
    for (int a = 0; a < 2; ++a)
#pragma unroll
        for (int b = 0; b < 2; ++b)
#pragma unroll
            for (int m = 0; m < 4; ++m)
#pragma unroll
                for (int n = 0; n < 2; ++n) acc[a][b][m][n] = (f32x4){0.f, 0.f, 0.f, 0.f}; }
    bf16x8 At[4][2], B0[2][2], B1[2][2];
    PG8_ROWOFF(vc, 0);
    const char* cA = GATHER ? (const char*)g.A : (const char*)g.A + (size_t)cur.pm * tstep;
    const char* cB = (const char*)g.Bt + (size_t)cur.e * g.estride + (size_t)cur.pn * tstep;
    PG8_STAGE(PG8_SB(0, 0), cB, voffB); PG8_STAGE(PG8_SB(0, 1), cB + hstep, voffB); PG8_STAGE(PG8_SA(0, 0), cA, vc[0]); PG8_STAGE(PG8_SA(0, 1), cA, vc[1]);
    if (wr == 1) PG8_BAR;
    PG8_WAIT_V(2); PG8_BAR;
    PG8_STAGE(PG8_SB(1, 0), cB + kstep, voffB); PG8_STAGE(PG8_SA(1, 0), cA + kstep, vc[0]); PG8_STAGE(PG8_SB(1, 1), cB + hstep + kstep, voffB);
    PG8_WAIT_V(6); PG8_BAR;
    for (;;) {
        const bool has_next = S.next(ui + 1, nxt);
        const char* nA = GATHER ? cA : (has_next ? (const char*)g.A + (size_t)nxt.pm * tstep : cA);
        const char* nB = has_next ? (const char*)g.Bt + (size_t)nxt.e * g.estride + (size_t)nxt.pn * tstep : cB;
        if constexpr (has_ldsbias<Epi>::v) { if (has_next && wid < 4) __builtin_amdgcn_global_load_lds((const unsigned*)(E.bias(nxt) + wid * 64 + lane), (LAS unsigned*)(E.bl + ((ui + 1) % 3) * 256 + wid * 64), 4, 0, 0); }
        if constexpr (GATHER) { if (has_next) { PG8_ROWOFF(vn, ui + 1); } else {
#pragma unroll
            for (int h = 0; h < 2; ++h)
#pragma unroll
                for (int i = 0; i < 2; ++i) vn[h][i] = vc[h][i]; } }
#pragma nounroll
        for (int t = 0; t < nt; t += 2) {
            const bool last = (t == nt - 2);
            const char* a1 = cA + (size_t)(t + 1) * kstep;
            const char* a2 = last ? nA : cA + (size_t)(t + 2) * kstep; const char* b2 = last ? nB : cB + (size_t)(t + 2) * kstep;
            const char* a3 = a2 + kstep; const char* b3 = b2 + kstep;
            unsigned w0[2], w1[2];
#pragma unroll
            for (int i = 0; i < 2; ++i) { w0[i] = (GATHER && last) ? vn[0][i] : vc[0][i]; w1[i] = (GATHER && last) ? vn[1][i] : vc[1][i]; }
            PG8_LDB(B0, 0, 0); PG8_LDB(B1, 0, 1); PG8_SCHED; PG8_LDA(At, 0, 0); PG8_STAGE(PG8_SA(1, 1), a1, vc[1]);
            PG8_WAIT_V(8); PG8_WAIT_L(0); PG8_BAR; PG8_MMA(0, 0, At, B0); PG8_MMA(0, 1, At, B1); PG8_BAR; PG8_SCHED;
            PG8_LDA(At, 0, 1); PG8_STAGE(PG8_SB(0, 0), b2, voffB); PG8_STAGE(PG8_SB(0, 1), b2 + hstep, voffB); PG8_STAGE(PG8_SA(0, 0), a2, w0);
            PG8_WAIT_V(8); PG8_WAIT_L(0); PG8_BAR; PG8_MMA(1, 0, At, B0); PG8_MMA(1, 1, At, B1); PG8_BAR; PG8_SCHED;
            PG8_LDB(B0, 1, 0); PG8_LDB(B1, 1, 1); PG8_SCHED; PG8_LDA(At, 1, 0); PG8_STAGE(PG8_SA(0, 1), a2, w1);
            PG8_WAIT_V(8); PG8_WAIT_L(0); PG8_BAR; PG8_MMA(0, 0, At, B0); PG8_MMA(0, 1, At, B1); PG8_BAR; PG8_SCHED;
            PG8_LDA(At, 1, 1); PG8_STAGE(PG8_SB(1, 0), b3, voffB); PG8_STAGE(PG8_SB(1, 1), b3 + hstep, voffB); PG8_STAGE(PG8_SA(1, 0), a3, w0);
            PG8_WAIT_V(8); PG8_WAIT_L(0); PG8_BAR; PG8_MMA(1, 0, At, B0); PG8_MMA(1, 1, At, B1); PG8_BAR; PG8_SCHED;
        }
        if constexpr (ALIGN_EPI) { if (wr == 0) PG8_BAR; }
        if constexpr (FLOW == 1) { if (pub_pm >= 0 && wid == 0 && lane == 0) __hip_atomic_fetch_add(g.rdy + pub_pm, 1u, __ATOMIC_RELAXED, __HIP_MEMORY_SCOPE_AGENT); }
        ride.begin(S.ord(ui), wid, lane);
        Unit nn; bool has2 = false; unsigned rv = 0; (void)has2; (void)rv;
        if constexpr (FLOW == 2) { has2 = S.next(ui + 2, nn); if (has2) rv = __hip_atomic_load(g.rdy + nn.pm, __ATOMIC_RELAXED, __HIP_MEMORY_SCOPE_AGENT); }
        if constexpr (FP8) asm volatile("s_nop 15\n\ts_nop 15" ::: "memory");
        E(acc, cur, ui, wr, wc, fr, fq);
        ride.end(lane);
        if constexpr (FLOW == 2) { if (has2 && (unsigned)__builtin_amdgcn_readfirstlane((int)rv) < (unsigned)FLOW_NEED) flow_wait(g.rdy + nn.pm, FLOW_NEED); }
        if constexpr (FLOW == 1) pub_pm = cur.pm;
        if (!has_next) break;
        if constexpr (has_accbias<Epi>::v) E.init(acc, ui + 1, wc, fq);
        else {
#pragma unroll
        for (int a = 0; a < 2; ++a)
#pragma unroll
            for (int b = 0; b < 2; ++b)
#pragma unroll
                for (int m = 0; m < 4; ++m)
#pragma unroll
                    for (int n = 0; n < 2; ++n) acc[a][b][m][n] = (f32x4){0.f, 0.f, 0.f, 0.f}; }
        cur = nxt; cA = nA; cB = nB; ++ui;
        if constexpr (GATHER) {
#pragma unroll
            for (int h = 0; h < 2; ++h)
#pragma unroll
                for (int i = 0; i < 2; ++i) vc[h][i] = vn[h][i]; }
        if constexpr (ALIGN_EPI) { if (wr == 1) PG8_BAR; }
    }
    PG8_WAIT_V(0);
    if constexpr (!ALIGN_EPI) { if (wr == 0) PG8_BAR; }
    PG8_BAR;
    if constexpr (FLOW == 1) { if (pub_pm >= 0 && wid == 0 && lane == 0) __hip_atomic_fetch_add(g.rdy + pub_pm, 1u, __ATOMIC_RELAXED, __HIP_MEMORY_SCOPE_AGENT); }
#undef PG8_SA
#undef PG8_SB
#undef PG8_STAGE
#undef PG8_LDA
#undef PG8_LDB
#undef PG8_MMA
#undef PG8_CAT
#undef PG8_WAIT_V
#undef PG8_WAIT_L
#undef PG8_BAR
#undef PG8_SCHED
#undef PG8_ROWOFF
}
}
namespace pg8 {
struct EpiInProj0 {
    static constexpr bool PERM = true;
    bf16 *Q0, *K0, *V0, *SG, *U; const float* rope;
    __device__ __forceinline__ void operator()(const f32x4 (&acc)[2][2][4][2], const Unit& u, int, int wr, int wc, int fr, int fq) const {
        const int row0 = u.pm * BM + wr * 64 + fr;
        if (u.pn < 2) {
            bf16* dst = u.pn == 0 ? Q0 : K0; const float sc = u.pn == 0 ? 1.f : 0.125f;
            f32x4 nc0, nc1, ns0, ns1;
            { const float* cp = rope + (row0 & (SEQ - 1)) * 32 + 8 * fq; const float* sp = cp + SEQ * 32; nc0 = *(const f32x4*)cp; nc1 = *(const f32x4*)(cp + 4); ns0 = *(const f32x4*)sp; ns1 = *(const f32x4*)(sp + 4); }
#pragma unroll
            for (int ai = 0; ai < 2; ++ai)
#pragma unroll
                for (int m = 0; m < 4; ++m) {
                    const int row = row0 + ai * HALF + m * 16;
                    const f32x4 c0 = nc0, c1 = nc1, s0 = ns0, s1 = ns1;
                    { const int gi = ai * 4 + m + 1;
                      if (gi < 8) { const int nrow = row0 + (gi >> 2) * HALF + (gi & 3) * 16; const float* cp = rope + (nrow & (SEQ - 1)) * 32 + 8 * fq; const float* sp = cp + SEQ * 32;
                          nc0 = *(const f32x4*)cp; nc1 = *(const f32x4*)(cp + 4); ns0 = *(const f32x4*)sp; ns1 = *(const f32x4*)(sp + 4); } }
                    const f32x4 a0 = acc[ai][0][m][0], a1 = acc[ai][0][m][1], b0 = acc[ai][1][m][0], b1 = acc[ai][1][m][1];
                    const f32x4 o10 = (a0 * c0 - b0 * s0) * sc, o11 = (a1 * c1 - b1 * s1) * sc, o20 = (b0 * c0 + a0 * s0) * sc, o21 = (b1 * c1 + a1 * s1) * sc;
                    bf16* p = dst + (size_t)row * 256 + 64 * wc + 8 * fq;
                    u32x4 w; w.x = cvt_pk_bf16(o10[0], o10[1]); w.y = cvt_pk_bf16(o10[2], o10[3]); w.z = cvt_pk_bf16(o11[0], o11[1]); w.w = cvt_pk_bf16(o11[2], o11[3]);
                    *(u32x4*)p = w;
                    w.x = cvt_pk_bf16(o20[0], o20[1]); w.y = cvt_pk_bf16(o20[2], o20[3]); w.z = cvt_pk_bf16(o21[0], o21[1]); w.w = cvt_pk_bf16(o21[2], o21[3]);
                    *(u32x4*)(p + 32) = w;
                    asm volatile("" ::: "memory");
                }
        } else if (u.pn < 6) {
            const bool isg = u.pn >= 4; bf16* dst = isg ? SG : V0; const int colb = 256 * ((u.pn - 2) & 1) + 32 * wc + 8 * fq;
#pragma unroll
            for (int ai = 0; ai < 2; ++ai)
#pragma unroll
                for (int m = 0; m < 4; ++m) {
                    const int row = row0 + ai * HALF + m * 16;
#pragma unroll
                    for (int bj = 0; bj < 2; ++bj) {
                        f32x4 v0 = acc[ai][bj][m][0], v1 = acc[ai][bj][m][1];
                        if (isg) {
#pragma unroll
                            for (int j = 0; j < 4; ++j) { v0[j] = v0[j] * sigmoidf_(v0[j]); v1[j] = v1[j] * sigmoidf_(v1[j]); } }
                        u32x4 w; w.x = cvt_pk_bf16(v0[0], v0[1]); w.y = cvt_pk_bf16(v0[2], v0[3]); w.z = cvt_pk_bf16(v1[0], v1[1]); w.w = cvt_pk_bf16(v1[2], v1[3]);
                        *(u32x4*)(dst + (size_t)row * 512 + colb + bj * HALF) = w;
                    }
                }
        } else {
            const int ch0 = 128 * (u.pn - 6) + 32 * wc + 8 * fq;
#pragma unroll
            for (int ai = 0; ai < 2; ++ai)
#pragma unroll
                for (int m = 0; m < 4; ++m) {
                    const int row = row0 + ai * HALF + m * 16;
                    f32x4 v0 = acc[ai][0][m][0], v1 = acc[ai][0][m][1]; const f32x4 g0 = acc[ai][1][m][0], g1 = acc[ai][1][m][1];
#pragma unroll
                    for (int j = 0; j < 4; ++j) { v0[j] = v0[j] * sigmoidf_(g0[j]); v1[j] = v1[j] * sigmoidf_(g1[j]); }
                    u32x4 w; w.x = cvt_pk_bf16(v0[0], v0[1]); w.y = cvt_pk_bf16(v0[2], v0[3]); w.z = cvt_pk_bf16(v1[0], v1[1]); w.w = cvt_pk_bf16(v1[2], v1[3]);
                    *(u32x4*)(U + (size_t)row * 512 + ch0) = w;
                }
        }
    }
};
template <bool RB> struct EpiResid {
    static constexpr bool PERM = true;
    const void* xres; bf16* y;
    struct RG { u32x4 w[2]; f32x4 x[2][2]; };
    __device__ __forceinline__ void load(RG& g, size_t off) const {
#pragma unroll
        for (int bj = 0; bj < 2; ++bj) {
            if constexpr (RB) g.w[bj] = *(const u32x4*)((const bf16*)xres + off + bj * HALF);
            else { g.x[bj][0] = *(const f32x4*)((const float*)xres + off + bj * HALF); g.x[bj][1] = *(const f32x4*)((const float*)xres + off + bj * HALF + 4); } }
    }
    __device__ __forceinline__ void operator()(const f32x4 (&acc)[2][2][4][2], const Unit& u, int, int wr, int wc, int fr, int fq) const {
        const int row0 = u.pm * BM + wr * 64 + fr, col0 = u.pn * BM + wc * 32 + 8 * fq;
        RG cur, nx; load(cur, (size_t)row0 * D + col0);
#pragma unroll
        for (int ai = 0; ai < 2; ++ai)
#pragma unroll
            for (int m = 0; m < 4; ++m) { const size_t off = (size_t)(row0 + ai * HALF + m * 16) * D + col0;
                const int gi = ai * 4 + m + 1;
                if (RB && gi < 8) load(nx, (size_t)(row0 + (gi >> 2) * HALF + (gi & 3) * 16) * D + col0);
#pragma unroll
                for (int bj = 0; bj < 2; ++bj) { f32x4 x0, x1;
                    if constexpr (RB) { const u32x4 w = cur.w[bj];
                        x0 = (f32x4){__uint_as_float(w.x << 16), __uint_as_float(w.x & 0xffff0000u), __uint_as_float(w.y << 16), __uint_as_float(w.y & 0xffff0000u)};
                        x1 = (f32x4){__uint_as_float(w.z << 16), __uint_as_float(w.z & 0xffff0000u), __uint_as_float(w.w << 16), __uint_as_float(w.w & 0xffff0000u)}; }
                    else { x0 = cur.x[bj][0]; x1 = cur.x[bj][1]; }
                    const f32x4 v0 = x0 * ALPHA + acc[ai][bj][m][0], v1 = x1 * ALPHA + acc[ai][bj][m][1];
                    u32x4 w; w.x = cvt_pk_bf16(v0[0], v0[1]); w.y = cvt_pk_bf16(v0[2], v0[3]); w.z = cvt_pk_bf16(v1[0], v1[1]); w.w = cvt_pk_bf16(v1[2], v1[3]);
                    *(u32x4*)(y + off + bj * HALF) = w; }
                asm volatile("" ::: "memory");
                if constexpr (RB) cur = nx; else if (gi < 8) load(cur, (size_t)(row0 + (gi >> 2) * HALF + (gi & 3) * 16) * D + col0); }
    }
};
template <bool F8> struct EpiUp {
    static constexpr bool PERM = true, LDSBIAS = true, ACCBIAS = true;
    const float* bup; void* act; LAS float* bl;
    __device__ __forceinline__ const float* bias(const Unit& u) const { return bup + (size_t)u.e * 2 * FF + 256 * u.pn; }
    __device__ __forceinline__ void init(f32x4 (&acc)[2][2][4][2], int ui, int wc, int fq) const {
        const LAS float* bp = bl + (ui % 3) * 256 + 64 * wc + 16 * fq;
        const f32x4 q0 = *(const LAS f32x4*)bp, q1 = *(const LAS f32x4*)(bp + 4), q2 = *(const LAS f32x4*)(bp + 8), q3 = *(const LAS f32x4*)(bp + 12);
        const f32x4 bg0 = {q0[0], q0[2], q1[0], q1[2]}, bl0 = {q0[1], q0[3], q1[1], q1[3]}, bg1 = {q2[0], q2[2], q3[0], q3[2]}, bl1 = {q2[1], q2[3], q3[1], q3[3]};
#pragma unroll
        for (int ai = 0; ai < 2; ++ai)
#pragma unroll
            for (int m = 0; m < 4; ++m) { acc[ai][0][m][0] = bg0; acc[ai][0][m][1] = bg1; acc[ai][1][m][0] = bl0; acc[ai][1][m][1] = bl1; }
    }
    __device__ __forceinline__ void operator()(const f32x4 (&acc)[2][2][4][2], const Unit& u, int ui, int wr, int wc, int fr, int fq) const {
        const int ch0 = 128 * u.pn + 32 * wc + 8 * fq;
        const int row0 = u.pm * BM + wr * 64 + fr;
#pragma unroll
        for (int ai = 0; ai < 2; ++ai)
#pragma unroll
            for (int m = 0; m < 4; ++m) {
                const int row = row0 + ai * HALF + m * 16;
                const f32x4 g0 = swiglu4(acc[ai][0][m][0], acc[ai][1][m][0], F8 ? (float)(1 << SH_ACT) : 1.f), g1 = swiglu4(acc[ai][0][m][1], acc[ai][1][m][1], F8 ? (float)(1 << SH_ACT) : 1.f);
                if constexpr (F8) { u32x2 w; w.x = pk4_fp8_inrange(g0[0], g0[1], g0[2], g0[3]); w.y = pk4_fp8_inrange(g1[0], g1[1], g1[2], g1[3]);
                    *(u32x2*)((unsigned char*)act + (size_t)row * FF + ch0) = w; }
                else { u32x4 w; w.x = cvt_pk_bf16(g0[0], g0[1]); w.y = cvt_pk_bf16(g0[2], g0[3]); w.z = cvt_pk_bf16(g1[0], g1[1]); w.w = cvt_pk_bf16(g1[2], g1[3]);
                    *(u32x4*)((bf16*)act + (size_t)row * FF + ch0) = w; }
                asm volatile("" ::: "memory");
            }
    }
};
struct EpiDown {
    static constexpr bool PERM = true, LDSBIAS = true, ACCBIAS = true;
    const float* bdn; bf16* yslot; const LAS int* ttok; const LAS float* tgate; LAS float* bl;
    __device__ __forceinline__ const float* bias(const Unit& u) const { return bdn + (size_t)u.e * D + 256 * u.pn; }
    __device__ __forceinline__ void init(f32x4 (&acc)[2][2][4][2], int ui, int wc, int fq) const {
#pragma unroll
        for (int bj = 0; bj < 2; ++bj)
#pragma unroll
            for (int n = 0; n < 2; ++n) { const f32x4 bv = *(const LAS f32x4*)(bl + (ui % 3) * 256 + wc * 32 + 8 * fq + bj * HALF + 4 * n);
#pragma unroll
                for (int ai = 0; ai < 2; ++ai)
#pragma unroll
                    for (int m = 0; m < 4; ++m) acc[ai][bj][m][n] = bv; }
    }
    __device__ __forceinline__ void operator()(const f32x4 (&acc)[2][2][4][2], const Unit& u, int ui, int wr, int wc, int fr, int fq) const {
        const int col0 = u.pn * BM + wc * 32 + 8 * fq;
#pragma unroll
        for (int ai = 0; ai < 2; ++ai)
#pragma unroll
            for (int m = 0; m < 4; ++m) {
                const int r = ai * HALF + wr * 64 + m * 16 + fr; const int tok4 = ttok[ui * 256 + r]; const float gt = tgate[ui * 256 + r] * (YS8 ? (float)(1 << SH_Y) : 1.f);
                if (tok4 >= 0) {
#pragma unroll
                    for (int bj = 0; bj < 2; ++bj) { const f32x4 v0 = acc[ai][bj][m][0] * gt, v1 = acc[ai][bj][m][1] * gt;
                        if constexpr (YS8) { u32x2 w; w.x = pk4_fp8(v0[0], v0[1], v0[2], v0[3]); w.y = pk4_fp8(v1[0], v1[1], v1[2], v1[3]);
                            *(u32x2*)((unsigned char*)yslot + (size_t)tok4 * D + col0 + bj * HALF) = w; }
                        else { u32x4 w; w.x = cvt_pk_bf16(v0[0], v0[1]); w.y = cvt_pk_bf16(v0[2], v0[3]); w.z = cvt_pk_bf16(v1[0], v1[1]); w.w = cvt_pk_bf16(v1[2], v1[3]);
                            *(u32x4*)(yslot + (size_t)tok4 * D + col0 + bj * HALF) = w; } }
                }
                asm volatile("" ::: "memory");
            }
    }
};
struct EpiBf16 {
    static constexpr bool PERM = true;
    bf16* O; int ldc; int split_cols; size_t split_stride; float scale0;
    __device__ __forceinline__ void operator()(const f32x4 (&acc)[2][2][4][2], const Unit& u, int, int wr, int wc, int fr, int fq) const {
        const int row0 = u.pm * BM + wr * 64 + fr; int colt = u.pn * BM; bf16* base = O; float sc = 1.f;
        if (split_cols) { const int t = colt / split_cols; base += (size_t)t * split_stride; colt -= t * split_cols; if (t == 0) sc = scale0; }
        const int col0 = colt + wc * 32 + 8 * fq;
#pragma unroll
        for (int ai = 0; ai < 2; ++ai)
#pragma unroll
            for (int m = 0; m < 4; ++m) { bf16* rowp = base + (size_t)(row0 + ai * HALF + m * 16) * ldc + col0;
#pragma unroll
                for (int bj = 0; bj < 2; ++bj) { const f32x4 v0 = acc[ai][bj][m][0] * sc, v1 = acc[ai][bj][m][1] * sc;
                    u32x4 w; w.x = cvt_pk_bf16(v0[0], v0[1]); w.y = cvt_pk_bf16(v0[2], v0[3]); w.z = cvt_pk_bf16(v1[0], v1[1]); w.w = cvt_pk_bf16(v1[2], v1[3]);
                    *(u32x4*)(rowp + bj * HALF) = w; } }
    }
};
__device__ __forceinline__ int pi32(int r) { return (r & 0x13) | ((r & 4) << 1) | ((r & 8) >> 1); }
struct EpiQK {
    static constexpr bool PERM = true;
    bf16* Q; bf16* Kf; float qscale;
    __device__ __forceinline__ void operator()(const f32x4 (&acc)[2][2][4][2], const Unit& u, int, int wr, int wc, int fr, int fq) const {
        const int row0 = u.pm * BM + wr * 64 + fr; const bool isk = u.pn >= 4; const int colt = (u.pn & 3) * BM + wc * 32 + 8 * fq; const float sc = isk ? 1.f : qscale;
#pragma unroll
        for (int ai = 0; ai < 2; ++ai)
#pragma unroll
            for (int m = 0; m < 4; ++m) { const int row = row0 + ai * HALF + m * 16;
#pragma unroll
                for (int bj = 0; bj < 2; ++bj) { const f32x4 v0 = acc[ai][bj][m][0] * sc, v1 = acc[ai][bj][m][1] * sc; const int col = colt + bj * HALF;
                    u32x4 w; w.x = cvt_pk_bf16(v0[0], v0[1]); w.y = cvt_pk_bf16(v0[2], v0[3]); w.z = cvt_pk_bf16(v1[0], v1[1]); w.w = cvt_pk_bf16(v1[2], v1[3]);
                    if (isk) { const int b = row >> 12, t = row & (SEQ - 1), h = col >> 7, c16 = (col & 127) >> 3;
                        *(u32x4*)(Kf + ((size_t)(b * 8 + h) * SEQ + (t & ~31)) * 128 + ((c16 >> 1) * 64 + (c16 & 1) * 32 + pi32(t & 31)) * 8) = w; }
                    else *(u32x4*)(Q + (size_t)row * D + col) = w; } }
    }
};
struct EpiVT {
    static constexpr bool PERM = true;
    bf16* Vf;
    __device__ __forceinline__ void operator()(const f32x4 (&acc)[2][2][4][2], const Unit& u, int, int wr, int wc, int fr, int fq) const {
        const int row0 = u.pm * BM + wr * 64 + fr, colt = u.pn * BM + wc * 32 + 8 * fq;
#pragma unroll
        for (int ai = 0; ai < 2; ++ai)
#pragma unroll
            for (int m = 0; m < 4; ++m) { const int row = row0 + ai * HALF + m * 16, h = row >> 7, e = row & 127;
#pragma unroll
                for (int bj = 0; bj < 2; ++bj) { const f32x4 v0 = acc[ai][bj][m][0], v1 = acc[ai][bj][m][1]; const int tok = colt + bj * HALF, b = tok >> 12, t = tok & (SEQ - 1);
                    u32x4 w; w.x = cvt_pk_bf16(v0[0], v0[1]); w.y = cvt_pk_bf16(v0[2], v0[3]); w.z = cvt_pk_bf16(v1[0], v1[1]); w.w = cvt_pk_bf16(v1[2], v1[3]);
                    *(u32x4*)(Vf + ((size_t)(b * 8 + h) * SEQ + (t & ~31)) * 128 + ((((t >> 4) & 1) * 4 + (e >> 5)) * 64 + ((t >> 3) & 1) * 32 + (e & 31)) * 8) = w; } }
    }
};
}

typedef GAS unsigned gu32;
#define RLX_AGENT __ATOMIC_RELAXED, __HIP_MEMORY_SCOPE_AGENT
#define LDS_WAIT() asm volatile("s_waitcnt lgkmcnt(0)" ::: "memory")
#define VM_WAIT() asm volatile("s_waitcnt vmcnt(0)" ::: "memory")
#define XB_TMO      128
#define XB_XCNT(j)  (256  + 64 * (j))
#define XB_XSUB(j)  (1280 + 64 * (j))
#define XB_XGEN(j)  (2304 + 64 * (j))
#define XB_TOP      3328
#define XB_TOPGEN   3392
#define XCD_BAR_WORDS 3456
#define XB_SPIN_CAP (1u << 18)
__device__ __forceinline__ unsigned xb_ld(unsigned* p)              { return __hip_atomic_load(p, __ATOMIC_RELAXED, __HIP_MEMORY_SCOPE_AGENT); }
__device__ __forceinline__ unsigned xb_add(unsigned* p, unsigned v) { return __hip_atomic_fetch_add(p, v, __ATOMIC_RELAXED, __HIP_MEMORY_SCOPE_AGENT); }
__device__ __forceinline__ unsigned xb_xcc_id() { return (unsigned)__builtin_amdgcn_s_getreg((3 << 11) | 20) & 0xFu; }
#define XB_SPIN(cond, bar) do { unsigned _sp = 0; while (cond) { __builtin_amdgcn_s_sleep(1); \
    if ((++_sp & 255u) == 0u) { if (xb_ld(&(bar)[XB_TMO])) break; if (_sp > XB_SPIN_CAP) { atomicAdd(&(bar)[XB_TMO], 1u); break; } } } } while (0)
struct XcdBarrier { unsigned* bar; unsigned x; volatile LAS unsigned* st; };
__device__ __forceinline__ XcdBarrier xcd_barrier_post(unsigned* bar, volatile LAS unsigned* st) {
    XcdBarrier b; b.bar = bar; b.x = xb_xcc_id(); b.st = st;
    if (threadIdx.x == 0) { const unsigned rank = xb_add(&bar[XB_XCNT(b.x)], 1u); st[2] = rank; st[3] = b.x; }
    return b;
}
__device__ __forceinline__ void xcd_barrier_complete(unsigned* bar, unsigned x, unsigned& nloc, unsigned& nx) {
    const unsigned G = gridDim.x * gridDim.y * gridDim.z;
    unsigned sum, cnt, mine, sp = 0u;
    for (;;) {
        sum = 0u; cnt = 0u; mine = 0u;
#pragma unroll
        for (unsigned j = 0; j < 16; ++j) { const unsigned c = xb_ld(&bar[XB_XCNT(j)]); sum += c; cnt += (c > 0u) ? 1u : 0u; mine = (j == x) ? c : mine; }
        if (sum == G) break;
        __builtin_amdgcn_s_sleep(1);
        if ((++sp & 255u) == 0u) { if (xb_ld(&bar[XB_TMO])) break; if (sp > XB_SPIN_CAP) { atomicAdd(&bar[XB_TMO], 1u); break; } }
    }
    nloc = mine > 0u ? mine : 1u; nx = cnt > 0u ? cnt : 1u;
}
__device__ __forceinline__ void xcd_barrier(const XcdBarrier& b) {
    asm volatile("s_waitcnt vmcnt(0)" ::: "memory");
    __syncthreads();
    if (threadIdx.x == 0) {
        unsigned* bar = b.bar;
        __builtin_amdgcn_s_waitcnt(0);
        unsigned nloc = b.st[0], nx = b.st[1];
        if (nloc == 0u) { xcd_barrier_complete(bar, b.x, nloc, nx); b.st[0] = nloc; b.st[1] = nx; }
        const unsigned old = xb_add(&bar[XB_XSUB(b.x)], 1u);
        const unsigned gen = old / nloc;
        if (old + 1u == (gen + 1u) * nloc) {
            __builtin_amdgcn_fence(__ATOMIC_RELEASE, "agent");
            asm volatile("s_waitcnt vmcnt(0)" ::: "memory");
            const unsigned og = xb_add(&bar[XB_TOP], 1u);
            const unsigned tg = og / nx;
            if (og + 1u == (tg + 1u) * nx) xb_add(&bar[XB_TOPGEN], 1u);
            else XB_SPIN(xb_ld(&bar[XB_TOPGEN]) == tg, bar);
            __builtin_amdgcn_fence(__ATOMIC_ACQUIRE, "agent");
            xb_add(&bar[XB_XGEN(b.x)], 1u);
            asm volatile("s_waitcnt vmcnt(0)" ::: "memory");
        } else {
            XB_SPIN(xb_ld(&bar[XB_XGEN(b.x)]) == gen, bar);
            __builtin_amdgcn_fence(__ATOMIC_ACQUIRE, "agent");
            asm volatile("s_waitcnt vmcnt(0)" ::: "memory");
        }
    }
    __syncthreads();
}
constexpr int NWAVES = 8;
constexpr int RING_OFF = 0, RING_BYTES = 131072;
constexpr int AUX_OFF = 131072, AUX_BYTES = 15360;
constexpr int LCTL_OFF = AUX_OFF + AUX_BYTES;
constexpr int LDS_BYTES = 147456;
static_assert(LCTL_OFF + 1024 == LDS_BYTES, "LDS map");

struct Params { const float* in[30]; float* out; unsigned char* ws; int ph_lo, ph_hi, li, pad; };

struct Frame { LAS unsigned char* lds; int G, bid, wave, xok; };
typedef const __attribute__((address_space(4))) Params* KParams;
__device__ __forceinline__ KParams kargs() { KParams p = (KParams)__builtin_amdgcn_kernarg_segment_ptr(); asm volatile("" : "+s"(p)); return p; }
#define PHASE_PROLOGUE() int lane_ = (int)__builtin_amdgcn_mbcnt_hi(~0u, __builtin_amdgcn_mbcnt_lo(~0u, 0u)); asm volatile("" : "+v"(lane_)); const int lane = lane_, wave = F.wave, tid = wave * 64 + lane; \
    KParams P = kargs(); unsigned char* const ws = P->ws; unsigned* const ctl = (unsigned*)(ws + WS_CTL); (void)tid; (void)ctl
#define WSP(T, off) ((T*)(ws + (off)))

__device__ __forceinline__ int rowmap(int kind, int n) {
    if (kind == 1) {
        if (n < 512) { const int base = n & 256, r = n & 255, h = r >> 6, bj = (r >> 5) & 1, dd = r & 31; return base + 128 * bj + 32 * h + dd; }
        if (n < 1536) return n;
        if (n < 2048) { const int i = n - 1536; return 1536 + 256 * (i >> 7) + (i & 127); }
        const int i = n - 2048; return 1536 + 256 * (i >> 7) + 128 + (i & 127);
    }
    if (kind == 2) { const int ch = n >> 1; return 256 * (ch >> 7) + 128 * (n & 1) + (ch & 127); }
    return n;
}
__device__ __forceinline__ void p0_item(const float* W, int K, int N, bf16* WT, int kind, LAS float* scr, int kb, int nb, int lane) {
    const int k0 = 64 * kb, n0 = 64 * nb;
    f32x4 v[16];
#pragma unroll
    for (int i = 0; i < 16; ++i) v[i] = *(const f32x4*)(W + (size_t)(k0 + 4 * i + (lane >> 4)) * N + n0 + 4 * (lane & 15));
#pragma unroll
    for (int i = 0; i < 16; ++i) { LAS float* s = scr + (4 * i + (lane >> 4)) * 65 + 4 * (lane & 15); s[0] = v[i][0]; s[1] = v[i][1]; s[2] = v[i][2]; s[3] = v[i][3]; }
    LDS_WAIT(); asm volatile("" ::: "memory");
    const int c = lane & 7;
#pragma unroll
    for (int j = 0; j < 8; ++j) { const int n = (lane >> 3) + 8 * j; const LAS float* s = scr + (8 * c) * 65 + n;
        u32x4 o; o.x = pk2(s[0], s[65]); o.y = pk2(s[130], s[195]); o.z = pk2(s[260], s[325]); o.w = pk2(s[390], s[455]);
        *(u32x4*)(WT + (size_t)rowmap(kind, n0 + n) * K + k0 + 8 * c) = o; }
    LDS_WAIT(); asm volatile("" ::: "memory");
}
constexpr int I_UP = NE * 16 * 32, I_DN = NE * 16 * 16, MOE_ITEMS_L = I_UP + I_DN, MOE_ITEMS = 2 * MOE_ITEMS_L;
struct ItemD { const float* W; unsigned char* WT; int N, kind, sh, k0, n0; };
__device__ __forceinline__ ItemD moe_item_desc(KParams P, unsigned char* ws, int idx) {
    ItemD d; const int l = idx >= MOE_ITEMS_L; int r = idx - l * MOE_ITEMS_L;
    if (r < I_UP) { const int e = r >> 9, q = r & 511; d.W = P->in[l ? 24 : 12] + (size_t)e * D * 2 * FF; d.WT = ws + (l ? WS_WUP1 : WS_WUP0) + (size_t)e * 2 * FF * D; d.N = 2 * FF; d.kind = 2; d.sh = SH_WUP; d.k0 = 64 * (q >> 5); d.n0 = 64 * (q & 31); }
    else { r -= I_UP; const int e = r >> 8, q = r & 255; d.W = P->in[l ? 26 : 14] + (size_t)e * FF * D; d.WT = ws + (l ? WS_WDN1 : WS_WDN0) + (size_t)e * D * FF; d.N = D; d.kind = 0; d.sh = SH_WDN; d.k0 = 64 * (q >> 4); d.n0 = 64 * (q & 15); }
    return d;
}
__device__ __forceinline__ void item8_load(f32x4 (&v)[16], const ItemD& d, int lane) {
#pragma unroll
    for (int i = 0; i < 16; ++i) v[i] = __builtin_nontemporal_load((const f32x4*)(d.W + (size_t)(d.k0 + 16 * (lane >> 4) + i) * d.N + d.n0 + 4 * (lane & 15)));
}
__device__ __forceinline__ void item8_finish(const f32x4 (&v)[16], const ItemD& d, int lane) {
    const float sc = (float)(1 << d.sh);
#pragma unroll
    for (int j = 0; j < 4; ++j) { u32x4 w;
        w.x = pk4_fp8(v[0][j] * sc, v[1][j] * sc, v[2][j] * sc, v[3][j] * sc); w.y = pk4_fp8(v[4][j] * sc, v[5][j] * sc, v[6][j] * sc, v[7][j] * sc);
        w.z = pk4_fp8(v[8][j] * sc, v[9][j] * sc, v[10][j] * sc, v[11][j] * sc); w.w = pk4_fp8(v[12][j] * sc, v[13][j] * sc, v[14][j] * sc, v[15][j] * sc);
        *(u32x4*)(d.WT + (size_t)rowmap(d.kind, d.n0 + 4 * (lane & 15) + j) * 1024 + d.k0 + 16 * (lane >> 4)) = w; }
}
struct MoeRide {
    KParams P; unsigned char* ws; int base, limit; ItemD d; f32x4 v[16]; bool ok;
    __device__ __forceinline__ void begin(int L, int w, int lane) { asm volatile("" : "+v"(lane));
        const int idx = base + 8 * L + w; ok = idx < limit; d = moe_item_desc(P, ws, ok ? idx : limit - 1);
        if (ok) item8_load(v, d, lane); else {
#pragma unroll
            for (int i = 0; i < 16; ++i) v[i] = (f32x4){0.f, 0.f, 0.f, 0.f}; } }
    __device__ __forceinline__ void end(int lane) { if (ok) item8_finish(v, d, lane); }
};
__device__ __forceinline__ void moe_convert(Frame& F, int first, int n, int stride, int limit) {
    PHASE_PROLOGUE();
    if (n > 0 && first + (n - 1) * stride >= limit) n = (limit - first + stride - 1) / stride;
    if (n <= 0) return;
    f32x4 vc[16], vn[16];
    ItemD dc = moe_item_desc(P, ws, first), dn = dc;
    item8_load(vc, dc, lane);
    for (int k = 0; k < n; ++k) {
        const bool more = k + 1 < n;
        if (more) { dn = moe_item_desc(P, ws, first + (k + 1) * stride); item8_load(vn, dn, lane); }
        item8_finish(vc, dc, lane);
        if (more) { dc = dn;
#pragma unroll
            for (int i = 0; i < 16; ++i) vc[i] = vn[i]; }
    }
}
__device__ __forceinline__ void moe_convert3(Frame& F, int first, int n, int stride, int limit) {
    PHASE_PROLOGUE();
    if (n > 0 && first + (n - 1) * stride >= limit) n = (limit - first + stride - 1) / stride;
    if (n <= 0) return;
    f32x4 va[16], vb[16], vc[16];
    ItemD da = moe_item_desc(P, ws, first), db = da, dc = da;
    item8_load(va, da, lane);
    if (n > 1) { db = moe_item_desc(P, ws, first + stride); item8_load(vb, db, lane); }
    for (int k = 0; k < n; k += 3) {
        if (k + 2 < n) { dc = moe_item_desc(P, ws, first + (k + 2) * stride); item8_load(vc, dc, lane); }
        item8_finish(va, da, lane);
        if (k + 1 >= n) break;
        if (k + 3 < n) { da = moe_item_desc(P, ws, first + (k + 3) * stride); item8_load(va, da, lane); }
        item8_finish(vb, db, lane);
        if (k + 2 >= n) break;
        if (k + 4 < n) { db = moe_item_desc(P, ws, first + (k + 4) * stride); item8_load(vb, db, lane); }
        item8_finish(vc, dc, lane);
    }
}
__device__ __forceinline__ void p0_item8(const float* W, int K, int N, unsigned char* WT, int kind, int sh, LAS float* scr, int kb, int nb, int lane) {
    const int k0 = 64 * kb, n0 = 64 * nb;
    f32x4 v[16];
#pragma unroll
    for (int i = 0; i < 16; ++i) v[i] = *(const f32x4*)(W + (size_t)(k0 + 4 * i + (lane >> 4)) * N + n0 + 4 * (lane & 15));
#pragma unroll
    for (int i = 0; i < 16; ++i) { LAS float* s = scr + (4 * i + (lane >> 4)) * 65 + 4 * (lane & 15); s[0] = v[i][0]; s[1] = v[i][1]; s[2] = v[i][2]; s[3] = v[i][3]; }
    LDS_WAIT(); asm volatile("" ::: "memory");
    const float sc = (float)(1 << sh); const LAS float* s = scr + lane;
    unsigned char* o = WT + (size_t)rowmap(kind, n0 + lane) * K + k0;
#pragma unroll
    for (int j = 0; j < 4; ++j) { u32x4 w;
        w.x = pk4_fp8(s[(16 * j + 0) * 65] * sc, s[(16 * j + 1) * 65] * sc, s[(16 * j + 2) * 65] * sc, s[(16 * j + 3) * 65] * sc);
        w.y = pk4_fp8(s[(16 * j + 4) * 65] * sc, s[(16 * j + 5) * 65] * sc, s[(16 * j + 6) * 65] * sc, s[(16 * j + 7) * 65] * sc);
        w.z = pk4_fp8(s[(16 * j + 8) * 65] * sc, s[(16 * j + 9) * 65] * sc, s[(16 * j + 10) * 65] * sc, s[(16 * j + 11) * 65] * sc);
        w.w = pk4_fp8(s[(16 * j + 12) * 65] * sc, s[(16 * j + 13) * 65] * sc, s[(16 * j + 14) * 65] * sc, s[(16 * j + 15) * 65] * sc);
        *(u32x4*)(o + 16 * j) = w; }
    LDS_WAIT(); asm volatile("" ::: "memory");
}
constexpr int CONV_C1 = 64, CONV_P2 = 1024 * 8, CONV_A0 = MOE_ITEMS_L - 128 * CONV_C1 - CONV_P2;
__device__ __forceinline__ void p0_prep(Frame& F) {
    PHASE_PROLOGUE();
    LAS float* scr = (LAS float*)(F.lds + wave * 16640);
    const int gw = F.bid * NWAVES + wave, NGW = F.G * NWAVES;
    constexpr int I_IN0 = 16 * 40, I_O = 16 * 16, I_IN1 = 16 * 48;
    constexpr int NITEMS = I_IN0 + 2 * I_O + I_IN1;
    for (int it = gw; it < NITEMS; it += NGW) {
        int r = it;
        if (r < I_IN0) { p0_item(P->in[1], D, L0N, WSP(bf16, WS_WIN0), 1, scr, r / 40, r % 40, lane); continue; } r -= I_IN0;
        if (r < I_O) { p0_item8(P->in[7], D, D, WSP(unsigned char, WS_WOUT0), 0, SH_WOUT, scr, r >> 4, r & 15, lane); continue; } r -= I_O;
        if (r < I_IN1) { p0_item(P->in[18], D, 3 * D, WSP(bf16, WS_WIN1), 0, scr, r / 48, r % 48, lane); continue; } r -= I_IN1;
        p0_item8(P->in[19], D, D, WSP(unsigned char, WS_WOUT1), 0, SH_WOUT, scr, r >> 4, r & 15, lane);
    }
    static_assert(MOE_FP8[0] && MOE_FP8[1], "the conversion schedule assumes fp8 expert weights in both layers");
    moe_convert(F, gw, (CONV_A0 - gw + NGW - 1) / NGW, NGW, CONV_A0);
    { const float* x = P->in[0]; bf16* xb = WSP(bf16, WS_XBF);
      for (int m = gw; m < M; m += 4 * NGW) {
          f32x4 v[4][4];
#pragma unroll
          for (int q = 0; q < 4; ++q) { const f32x4* xr = (const f32x4*)(x + (size_t)(m + q * NGW) * D) + lane;
#pragma unroll
              for (int j = 0; j < 4; ++j) v[q][j] = xr[64 * j]; }
#pragma unroll
          for (int q = 0; q < 4; ++q) { u32x2* o = (u32x2*)(xb + (size_t)(m + q * NGW) * D) + lane;
#pragma unroll
              for (int j = 0; j < 4; ++j) { u32x2 w; w.x = pk2(v[q][j][0], v[q][j][1]); w.y = pk2(v[q][j][2], v[q][j][3]); o[64 * j] = w; } } } }
    static_assert(M % (4 * 2048) == 0, "bf16(x) loop: rows per trip");
    { bf16* rwf = WSP(bf16, WS_RWT);
      for (int i = gw * 64 + lane; i < 2 * 64 * 64; i += NGW * 64) { const int l = i >> 12, s = (i >> 6) & 63, ln = i & 63, e = ln & 31, h = ln >> 5; const float* rw = P->in[l ? 22 : 10];
          u32x4 hi4, lo4; unsigned hw[8], lw[8];
#pragma unroll
          for (int j = 0; j < 8; ++j) { const float w = rw[(16 * s + 8 * h + j) * NE + e]; const unsigned hb = f2bf(w); hw[j] = hb; lw[j] = f2bf(w - __uint_as_float(hb << 16)); }
          hi4.x = hw[0] | (hw[1] << 16); hi4.y = hw[2] | (hw[3] << 16); hi4.z = hw[4] | (hw[5] << 16); hi4.w = hw[6] | (hw[7] << 16);
          lo4.x = lw[0] | (lw[1] << 16); lo4.y = lw[2] | (lw[3] << 16); lo4.z = lw[4] | (lw[5] << 16); lo4.w = lw[6] | (lw[7] << 16);
          *(u32x4*)(rwf + ((size_t)(l * 2 + 0) * 4096 + s * 64 + ln) * 8) = hi4; *(u32x4*)(rwf + ((size_t)(l * 2 + 1) * 4096 + s * 64 + ln) * 8) = lo4; } }
    { float* rope = WSP(float, WS_ROPE);
      for (int i = gw * 64 + lane; i < SEQ * 32; i += NGW * 64) { const int pos = i >> 5, d = i & 31;
          const float inv = powf(10000.f, -(float)d / 32.f); const float ang = (float)pos * inv; rope[i] = cosf(ang); rope[SEQ * 32 + i] = sinf(ang); } }
}

__device__ __forceinline__ int crow(int r, int hi) { return (r & 3) + 8 * (r >> 2) + 4 * hi; }
__device__ __forceinline__ float head_log2g(int hd) { return log2f(1.f - exp2f(-5.f - (float)hd)); }

__device__ __forceinline__ void p2_kv_unit(Frame& F, int unit, int item) {
    PHASE_PROLOGUE();
    ItemD cd = moe_item_desc(P, ws, item); f32x4 cv[16]; item8_load(cv, cd, lane);
    const int bh = unit >> 6, c = unit & 63, b = bh >> 2, hd = bh & 3, r = lane & 31, h = lane >> 5, et = wave >> 1, dt = wave & 1;
    const bf16* K0 = WSP(bf16, WS_K0); const bf16* V0 = WSP(bf16, WS_V0); float* KV = WSP(float, WS_KV);
    const float l2g = head_log2g(hd);
    const size_t row0 = (size_t)b * SEQ + 64 * c;
    f32x16 acc = {};
#pragma unroll
    for (int s = 0; s < 4; ++s) {
        bf16x8 a, bb;
#pragma unroll
        for (int j = 0; j < 8; ++j) { const int m = 16 * s + 8 * h + j;
            a[j] = (short)V0[(row0 + m) * 512 + hd * 128 + 32 * et + r];
            const float kz = bf2f(K0[(row0 + m) * 256 + hd * 64 + 32 * dt + r]) * __builtin_amdgcn_exp2f((float)(63 - m) * l2g);
            bb[j] = (short)f2bf(kz); }
        acc = __builtin_amdgcn_mfma_f32_32x32x16_bf16(a, bb, acc, 0, 0, 0);
    }
    float* o = KV + ((size_t)unit * 128 + 32 * et) * 64 + 32 * dt + r;
#pragma unroll
    for (int g = 0; g < 16; ++g) o[crow(g, h) * 64] = acc[g];
    item8_finish(cv, cd, lane);
}
__device__ __forceinline__ void p2_scan(Frame& F) {
    PHASE_PROLOGUE();
    const float* KV = WSP(float, WS_KV); bf16* RT = WSP(bf16, WS_RT);
    for (int gid = F.bid * 512 + tid; gid < 16 * 8192; gid += F.G * 512) {
        const int bh = gid >> 13, rem = gid & 8191; const float gc = exp2f(64.f * head_log2g(bh & 3));
        float R = 0.f;
        float kv[16], kn[16];
#pragma unroll
        for (int i = 0; i < 16; ++i) kv[i] = KV[((size_t)(bh * 64 + i)) * 8192 + rem];
#pragma unroll
        for (int c0 = 0; c0 < 64; c0 += 16) {
            if (c0 + 16 < 64) {
#pragma unroll
                for (int i = 0; i < 16; ++i) kn[i] = KV[((size_t)(bh * 64 + c0 + 16 + i)) * 8192 + rem]; }
#pragma unroll
            for (int i = 0; i < 16; ++i) { RT[((size_t)(bh * 64 + c0 + i)) * 8192 + rem] = (bf16)f2bf(R); R = gc * R + kv[i]; }
#pragma unroll
            for (int i = 0; i < 16; ++i) kv[i] = kn[i];
        }
    }
}
__device__ __forceinline__ void p2_ret_wave(Frame& F, int wu) {
    PHASE_PROLOGUE();
    const int unit = wu >> 1, nt = wu & 1, bh = unit >> 6, c = unit & 63, b = bh >> 2, hd = bh & 3, r = lane & 31, h = lane >> 5;
    const bf16* Q0 = WSP(bf16, WS_Q0); const bf16* K0 = WSP(bf16, WS_K0); const bf16* V0 = WSP(bf16, WS_V0); const bf16* SG = WSP(bf16, WS_SG); const bf16* RT = WSP(bf16, WS_RT);
    bf16* mix = WSP(bf16, WS_MIX); const float* gng = P->in[2];
    const float l2g = head_log2g(hd);
    const size_t row0 = (size_t)b * SEQ + 64 * c;
    bf16x8 qf[4], kf[2][4], rf[4][4];
#pragma unroll
    for (int s = 0; s < 4; ++s) qf[s] = *(const bf16x8*)(Q0 + (row0 + 32 * nt + r) * 256 + hd * 64 + 16 * s + 8 * h);
#pragma unroll
    for (int et = 0; et < 4; ++et)
#pragma unroll
        for (int s = 0; s < 4; ++s) rf[et][s] = *(const bf16x8*)(RT + ((size_t)unit * 128 + 32 * et + r) * 64 + 16 * s + 8 * h);
#pragma unroll
    for (int mt = 0; mt < 2; ++mt)
#pragma unroll
        for (int s = 0; s < 4; ++s) kf[mt][s] = *(const bf16x8*)(K0 + (row0 + 32 * mt + r) * 256 + hd * 64 + 16 * s + 8 * h);
    __builtin_amdgcn_sched_barrier(0);
    f32x16 o[4];
#pragma unroll
    for (int et = 0; et < 4; ++et) { o[et] = (f32x16){};
#pragma unroll
        for (int s = 0; s < 4; ++s) o[et] = __builtin_amdgcn_mfma_f32_32x32x16_bf16(qf[s], rf[et][s], o[et], 0, 0, 0); }
    __builtin_amdgcn_sched_barrier(0);
    bf16x8 va[4], vb[4];
#define P2C_VLOAD(dst, mt_, s_) do { _Pragma("unroll") for (int et = 0; et < 4; ++et) { _Pragma("unroll") for (int j = 0; j < 8; ++j) { \
        const int m = 32 * (mt_) + 16 * (s_) + 8 * (j >> 2) + 4 * h + (j & 3); dst[et][j] = (short)V0[(row0 + m) * 512 + hd * 128 + 32 * et + r]; } } } while (0)
    P2C_VLOAD(va, 0, 0);
#pragma unroll
    for (int g = 0; g < 16; ++g) { const float xi = __builtin_amdgcn_exp2f((float)(32 * nt + crow(g, h) + 1) * l2g);
#pragma unroll
        for (int et = 0; et < 4; ++et) o[et][g] *= xi; }
#pragma unroll
    for (int mt = 0; mt < 2; ++mt) {
        f32x16 st = {};
#pragma unroll
        for (int s = 0; s < 4; ++s) st = __builtin_amdgcn_mfma_f32_32x32x16_bf16(kf[mt][s], qf[s], st, 0, 0, 0);
#pragma unroll
        for (int g = 0; g < 16; ++g) { const int dist = (32 * nt + r) - (32 * mt + crow(g, h)); st[g] *= __builtin_amdgcn_exp2f(fabsf((float)dist) * l2g); }
#pragma unroll
        for (int s = 0; s < 2; ++s) {
            u32x4 pw; pw.x = cvt_pk_bf16(st[8 * s + 0], st[8 * s + 1]); pw.y = cvt_pk_bf16(st[8 * s + 2], st[8 * s + 3]); pw.z = cvt_pk_bf16(st[8 * s + 4], st[8 * s + 5]); pw.w = cvt_pk_bf16(st[8 * s + 6], st[8 * s + 7]);
            if (mt * 2 + s < 3) { P2C_VLOAD(vb, (mt * 2 + s + 1) >> 1, (mt * 2 + s + 1) & 1); }
            __builtin_amdgcn_sched_barrier(0);
#pragma unroll
            for (int et = 0; et < 4; ++et) o[et] = __builtin_amdgcn_mfma_f32_32x32x16_bf16(__builtin_bit_cast(bf16x8, pw), va[et], o[et], 0, 0, 0);
            __builtin_amdgcn_sched_barrier(0);
#pragma unroll
            for (int et = 0; et < 4; ++et) va[et] = vb[et];
        }
    }
#undef P2C_VLOAD
    float sgv[4][16], ggv[4];
#pragma unroll
    for (int et = 0; et < 4; ++et) { ggv[et] = gng[hd * 128 + 32 * et + r];
#pragma unroll
        for (int g = 0; g < 16; ++g) sgv[et][g] = bf2f(SG[(row0 + 32 * nt + crow(g, h)) * 512 + hd * 128 + 32 * et + r]); }
    __builtin_amdgcn_sched_barrier(0);
    float mu[16], rs[16];
#pragma unroll
    for (int g = 0; g < 16; ++g) { float a = (o[0][g] + o[1][g]) + (o[2][g] + o[3][g]), q = (o[0][g] * o[0][g] + o[1][g] * o[1][g]) + (o[2][g] * o[2][g] + o[3][g] * o[3][g]);
        a = half32_sum(a); q = half32_sum(q);
        mu[g] = a * (1.f / 128.f); rs[g] = rsqrtf(fmaxf(q * (1.f / 128.f) - mu[g] * mu[g], 0.f) + LN_EPS); }
#pragma unroll
    for (int et = 0; et < 4; ++et) {
#pragma unroll
        for (int g = 0; g < 16; ++g) { const size_t row = row0 + 32 * nt + crow(g, h);
            ((unsigned char*)mix)[row * D + hd * 128 + 32 * et + r] = fp8_1((o[et][g] - mu[g]) * rs[g] * ggv[et] * sgv[et][g] * (float)(1 << SH_MIX)); } }
}
__device__ __forceinline__ void p2_conv_unit(Frame& F, int u) {
    PHASE_PROLOGUE();
    const bf16* U = WSP(bf16, WS_U); bf16* mix = WSP(bf16, WS_MIX);
    const float* cw = P->in[3]; const float* cb = P->in[4]; const float* lg = P->in[5]; const float* lb = P->in[6];
    const int r0 = 64 * u, t0 = r0 & (SEQ - 1), ch = tid;
    LAS float* Y = (LAS float*)(F.lds + RING_OFF);
    float w[31];
#pragma unroll
    for (int j = 0; j < 31; ++j) w[j] = cw[j * 512 + ch];
    const float cbias = cb[ch];
    for (int q = 0; q < 2; ++q) {
        float val[62];
#pragma unroll
        for (int i = 0; i < 62; ++i) { const int rel = 32 * q + i - 30; const bool ok = t0 + rel >= 0;
            const float x = bf2f(U[(size_t)(r0 + (ok ? rel : 0)) * 512 + ch]); val[i] = ok ? x : 0.f; }
        __builtin_amdgcn_sched_barrier(0);
#pragma unroll
        for (int o = 0; o < 32; ++o) { float a = cbias;
#pragma unroll
            for (int j = 0; j < 31; ++j) a += w[j] * val[o + j];
            Y[(32 * q + o) * 512 + ch] = a; }
    }
    __syncthreads();
    const f32x4 g0 = *(const f32x4*)(lg + 8 * lane), g1 = *(const f32x4*)(lg + 8 * lane + 4), b0 = *(const f32x4*)(lb + 8 * lane), b1 = *(const f32x4*)(lb + 8 * lane + 4);
    for (int tt = 0; tt < 8; ++tt) {
        const int tok = wave * 8 + tt; const LAS float* yr = Y + tok * 512 + 8 * lane;
        f32x4 a = *(const LAS f32x4*)yr, c = *(const LAS f32x4*)(yr + 4);
        const float mu = wave_sum((a[0] + a[1]) + (a[2] + a[3]) + (c[0] + c[1]) + (c[2] + c[3])) * (1.f / 512.f);
        a = a - mu; c = c - mu;
        const float var = wave_sum((a[0] * a[0] + a[1] * a[1]) + (a[2] * a[2] + a[3] * a[3]) + (c[0] * c[0] + c[1] * c[1]) + (c[2] * c[2] + c[3] * c[3])) * (1.f / 512.f);
        const float rstd = rsqrtf(var + LN_EPS);
        a = a * rstd * g0 + b0; c = c * rstd * g1 + b1;
#pragma unroll
        for (int j = 0; j < 4; ++j) { a[j] = a[j] * sigmoidf_(a[j]); c[j] = c[j] * sigmoidf_(c[j]); }
        const float sm = (float)(1 << SH_MIX);
        u32x2 o; o.x = pk4_fp8(a[0] * sm, a[1] * sm, a[2] * sm, a[3] * sm); o.y = pk4_fp8(c[0] * sm, c[1] * sm, c[2] * sm, c[3] * sm);
        *(u32x2*)((unsigned char*)mix + (size_t)(r0 + tok) * D + 512 + 8 * lane) = o;
    }
    __syncthreads();
}

constexpr int RT_RS = 1032;
constexpr int RT_XL = 32 * RT_RS * 2, RT_PART = 0, RT_LOG = 8 * 32 * 32 * 4, RT_SMALL = AUX_OFF + 4096;
__device__ __forceinline__ void p_router(Frame& F, int layer) {
    PHASE_PROLOGUE();
    const bf16* ypre = WSP(bf16, WS_YPRE); unsigned char* x1f8 = WSP(unsigned char, WS_X1F8);
    const float* g = P->in[layer ? 20 : 8]; const float* bb = P->in[layer ? 21 : 9]; const float* rb = P->in[layer ? 23 : 11];
    const bf16* rwh = WSP(bf16, WS_RWT) + (size_t)(layer * 2) * 4096 * 8; const bf16* rwl = rwh + 4096 * 8;
    unsigned* cnt = ctl + CW_CNT + layer * 2048; int* rowtok = WSP(int, WS_ROWTOK); float* rowgate = WSP(float, WS_ROWGATE);
    LAS bf16* XH = (LAS bf16*)(F.lds); LAS bf16* XL = (LAS bf16*)(F.lds + RT_XL);
    LAS float* PART = (LAS float*)(F.lds + RT_PART); LAS float* LOG = (LAS float*)(F.lds + RT_LOG);
    LAS int* lcnt = (LAS int*)(F.lds + RT_SMALL);
    LAS int* lbase = lcnt + 32;
    LAS int* sel_e = lcnt + 64;
    LAS int* sel_r = sel_e + 256;
    LAS float* sel_g = (LAS float*)(sel_r + 256);
    LAS float* topv = sel_g + 256;
    LAS int* topi = (LAS int*)(topv + 128);
    const int e_l = lane & 31, hi = lane >> 5;
    f32x4 gv[4], bv[4];
#pragma unroll
    for (int j = 0; j < 4; ++j) { gv[j] = *(const f32x4*)(g + 256 * j + 4 * lane); bv[j] = *(const f32x4*)(bb + 256 * j + 4 * lane); }
    const float rbc = rb[tid & 31];
    for (int chunk = (F.xok ? 32 * (F.bid & 7) + (F.bid >> 3) : F.bid); chunk < M / 64; chunk += F.G) {
        if (F.xok) pg8::flow_wait_wg(ctl + CW_RDY + 2048 + 64 * layer + (chunk >> 2), 4, wave);
        if (tid < 32) lcnt[tid] = 0;
        u32x2 yw[2][4][4];
#pragma unroll
        for (int rr = 0; rr < 4; ++rr)
#pragma unroll
            for (int j = 0; j < 4; ++j) { yw[0][rr][j] = *(const u32x2*)(ypre + ((size_t)chunk * 64 + wave * 4 + rr) * D + 256 * j + 4 * lane);
                yw[1][rr][j] = *(const u32x2*)(ypre + ((size_t)chunk * 64 + 32 + wave * 4 + rr) * D + 256 * j + 4 * lane); }
#pragma unroll
        for (int grp = 0; grp < 2; ++grp) {
            __syncthreads();
            bf16x8 bhf[8], blf[8];
#pragma unroll
            for (int ks = 0; ks < 8; ++ks) { const int s = wave * 8 + ks; bhf[ks] = *(const bf16x8*)(rwh + ((size_t)s * 64 + lane) * 8); blf[ks] = *(const bf16x8*)(rwl + ((size_t)s * 64 + lane) * 8); }
#pragma unroll
            for (int rr = 0; rr < 4; ++rr) {
                const int rl = wave * 4 + rr; const size_t row = (size_t)chunk * 64 + grp * 32 + rl;
                f32x4 v[4]; float s = 0.f;
#pragma unroll
                for (int j = 0; j < 4; ++j) { const u32x2 w = yw[grp][rr][j];
                    v[j] = (f32x4){__uint_as_float(w.x << 16), __uint_as_float(w.x & 0xffff0000u), __uint_as_float(w.y << 16), __uint_as_float(w.y & 0xffff0000u)}; s += (v[j][0] + v[j][1]) + (v[j][2] + v[j][3]); }
                const float mu = wave_sum(s) * (1.f / D); float q = 0.f;
#pragma unroll
                for (int j = 0; j < 4; ++j) { v[j] = v[j] - mu; q += (v[j][0] * v[j][0] + v[j][1] * v[j][1]) + (v[j][2] * v[j][2] + v[j][3] * v[j][3]); }
                const float rstd = rsqrtf(wave_sum(q) * (1.f / D) + LN_EPS);
#pragma unroll
                for (int j = 0; j < 4; ++j) { v[j] = v[j] * rstd * gv[j] + bv[j];
                    *(unsigned*)(x1f8 + row * D + 256 * j + 4 * lane) = pk4_fp8(v[j][0], v[j][1], v[j][2], v[j][3]);
                    u32x2 wh, wl; wh.x = cvt_pk_bf16(v[j][0], v[j][1]); wh.y = cvt_pk_bf16(v[j][2], v[j][3]);
                    wl.x = cvt_pk_bf16(v[j][0] - __uint_as_float(wh.x << 16), v[j][1] - __uint_as_float(wh.x & 0xffff0000u)); wl.y = cvt_pk_bf16(v[j][2] - __uint_as_float(wh.y << 16), v[j][3] - __uint_as_float(wh.y & 0xffff0000u));
                    *(LAS u32x2*)(XH + rl * RT_RS + 256 * j + 4 * lane) = wh; *(LAS u32x2*)(XL + rl * RT_RS + 256 * j + 4 * lane) = wl; }
            }
            __syncthreads();
            f32x16 acc = {};
#pragma unroll
            for (int ks = 0; ks < 8; ++ks) { const int s = wave * 8 + ks;
                const bf16x8 ah = *(const LAS bf16x8*)(XH + e_l * RT_RS + 16 * s + 8 * hi), al = *(const LAS bf16x8*)(XL + e_l * RT_RS + 16 * s + 8 * hi);
                const bf16x8 bh = bhf[ks], bl = blf[ks];
                acc = __builtin_amdgcn_mfma_f32_32x32x16_bf16(ah, bh, acc, 0, 0, 0); acc = __builtin_amdgcn_mfma_f32_32x32x16_bf16(al, bh, acc, 0, 0, 0); acc = __builtin_amdgcn_mfma_f32_32x32x16_bf16(ah, bl, acc, 0, 0, 0); }
            __syncthreads();
#pragma unroll
            for (int gq = 0; gq < 16; ++gq) PART[(wave * 32 + crow(gq, hi)) * 32 + e_l] = acc[gq];
            __syncthreads();
#pragma unroll
            for (int k = 0; k < 2; ++k) { const int idx = tid + 512 * k; float sm = 0.f;
#pragma unroll
                for (int w = 0; w < 8; ++w) sm += PART[w * 1024 + idx];
                LOG[idx] = sm + rbc; }
            __syncthreads();
            int l2 = lane; asm volatile("" : "+v"(l2)); const int e_l = l2 & 31, hi = l2 >> 5;
            for (int pr = 0; pr < 2; ++pr) {
                const int rl = wave * 4 + pr * 2 + hi; const LAS float* lrow = LOG + rl * 32;
                const float mine = lrow[e_l]; int rank = 0;
#pragma unroll
                for (int i = 0; i < 8; ++i) { const f32x4 o = *(const LAS f32x4*)(lrow + 4 * i);
#pragma unroll
                    for (int c = 0; c < 4; ++c) rank += (o[c] > mine || (o[c] == mine && 4 * i + c < e_l)) ? 1 : 0; }
                if (rank < 4) { topv[rl * 4 + rank] = mine; topi[rl * 4 + rank] = e_l; }
                if (e_l < 4) {
                    const f32x4 sv = *(const LAS f32x4*)(topv + rl * 4);
                    const float e1 = __expf(sv[1] - sv[0]), e2 = __expf(sv[2] - sv[0]), e3 = __expf(sv[3] - sv[0]);
                    const float inv = 1.f / (((1.f + e1) + e2) + e3);
                    const int ek = topi[rl * 4 + e_l];
                    const float gk = (e_l == 0 ? 1.f : e_l == 1 ? e1 : e_l == 2 ? e2 : e3) * inv;
                    const int lr = __hip_atomic_fetch_add(lcnt + ek, 1, __ATOMIC_RELAXED, __HIP_MEMORY_SCOPE_WORKGROUP);
                    const int idx = (grp * 32 + rl) * 4 + e_l; sel_e[idx] = ek; sel_g[idx] = gk; sel_r[idx] = lr;
                }
            }
        }
        __syncthreads();
        { int t2 = tid; asm volatile("" : "+v"(t2));
          if (t2 < 32) lbase[t2] = (int)__hip_atomic_fetch_add(cnt + 64 * t2, (unsigned)lcnt[t2], __ATOMIC_RELAXED, __HIP_MEMORY_SCOPE_AGENT);
          __syncthreads();
          if (t2 < 256) { const int e = sel_e[t2]; const int pos = lbase[e] + sel_r[t2];
              rowtok[e * CAP + pos] = (chunk * 64 + (t2 >> 2)) * 4 + (t2 & 3); rowgate[e * CAP + pos] = sel_g[t2]; } }
        __syncthreads();
    }
}

__device__ __forceinline__ void p_combine(Frame& F, int layer) {
    PHASE_PROLOGUE();
    const bf16* ypre = WSP(bf16, WS_YPRE); const bf16* ys = WSP(bf16, WS_YSLOT);
    const float* g = P->in[layer ? 28 : 16]; const float* bb = P->in[layer ? 29 : 17]; const float* g1 = P->in[layer ? 20 : 8]; const float* b1 = P->in[layer ? 21 : 9];
    float* xo = P->out; bf16* xob = WSP(bf16, WS_X2B);
    const int gw = F.bid * NWAVES + wave, NGW = F.G * NWAVES;
    f32x4 gv[4], bv[4];
#pragma unroll
    for (int j = 0; j < 4; ++j) { gv[j] = *(const f32x4*)(g + 256 * j + 4 * lane); bv[j] = *(const f32x4*)(bb + 256 * j + 4 * lane); }
    f32x4 g1v[4], b1v[4];
#pragma unroll
    for (int j = 0; j < 4; ++j) { g1v[j] = *(const f32x4*)(g1 + 256 * j + 4 * lane); b1v[j] = *(const f32x4*)(b1 + 256 * j + 4 * lane); }
    static_assert(YS8, "the prefetching combine reads fp8 slots");
    u32x2 pyw[4]; int psw[4][4];
#pragma unroll
    for (int j = 0; j < 4; ++j) { pyw[j] = *(const u32x2*)(ypre + (size_t)gw * D + 256 * j + 4 * lane);
#pragma unroll
        for (int k = 0; k < 4; ++k) psw[j][k] = *(const int*)((const unsigned char*)ys + ((size_t)gw * 4 + k) * D + 256 * j + 4 * lane); }
    for (int row = gw; row < M; row += NGW) {
        f32x4 v[4]; float s = 0.f;
        u32x2 cyw[4]; int csw[4][4];
#pragma unroll
        for (int j = 0; j < 4; ++j) { cyw[j] = pyw[j];
#pragma unroll
            for (int k = 0; k < 4; ++k) csw[j][k] = psw[j][k]; }
        if (row + NGW < M) { const size_t nr = (size_t)row + NGW;
#pragma unroll
            for (int j = 0; j < 4; ++j) { pyw[j] = *(const u32x2*)(ypre + nr * D + 256 * j + 4 * lane);
#pragma unroll
                for (int k = 0; k < 4; ++k) psw[j][k] = *(const int*)((const unsigned char*)ys + (nr * 4 + k) * D + 256 * j + 4 * lane); } }
        { float s1 = 0.f;
#pragma unroll
          for (int j = 0; j < 4; ++j) { const u32x2 w = cyw[j];
              v[j] = (f32x4){__uint_as_float(w.x << 16), __uint_as_float(w.x & 0xffff0000u), __uint_as_float(w.y << 16), __uint_as_float(w.y & 0xffff0000u)}; s1 += (v[j][0] + v[j][1]) + (v[j][2] + v[j][3]); }
          const float mu1 = wave_sum(s1) * (1.f / D); float q1 = 0.f;
#pragma unroll
          for (int j = 0; j < 4; ++j) { v[j] = v[j] - mu1; q1 += (v[j][0] * v[j][0] + v[j][1] * v[j][1]) + (v[j][2] * v[j][2] + v[j][3] * v[j][3]); }
          const float rstd1 = rsqrtf(wave_sum(q1) * (1.f / D) + LN_EPS);
#pragma unroll
          for (int j = 0; j < 4; ++j) v[j] = (v[j] * rstd1 * g1v[j] + b1v[j]) * ALPHA; }
#pragma unroll
        for (int j = 0; j < 4; ++j) {
#pragma unroll
            for (int k = 0; k < 4; ++k) {
                if constexpr (YS8) { const int w = csw[j][k]; const float iy = 1.f / (float)(1 << SH_Y);
                    const f32x2 lo = __builtin_amdgcn_cvt_pk_f32_fp8(w, false), hi = __builtin_amdgcn_cvt_pk_f32_fp8(w, true);
                    v[j][0] += lo[0] * iy; v[j][1] += lo[1] * iy; v[j][2] += hi[0] * iy; v[j][3] += hi[1] * iy; }
                else { const u32x2 w = *(const u32x2*)(ys + ((size_t)row * 4 + k) * D + 256 * j + 4 * lane);
                    v[j][0] += __uint_as_float(w.x << 16); v[j][1] += __uint_as_float(w.x & 0xffff0000u); v[j][2] += __uint_as_float(w.y << 16); v[j][3] += __uint_as_float(w.y & 0xffff0000u); } }
            s += (v[j][0] + v[j][1]) + (v[j][2] + v[j][3]); }
        const float mu = wave_sum(s) * (1.f / D); float q = 0.f;
#pragma unroll
        for (int j = 0; j < 4; ++j) { v[j] = v[j] - mu; q += (v[j][0] * v[j][0] + v[j][1] * v[j][1]) + (v[j][2] * v[j][2] + v[j][3] * v[j][3]); }
        const float rstd = rsqrtf(wave_sum(q) * (1.f / D) + LN_EPS);
#pragma unroll
        for (int j = 0; j < 4; ++j) { v[j] = v[j] * rstd * gv[j] + bv[j];
            if (layer) *(f32x4*)(xo + (size_t)row * D + 256 * j + 4 * lane) = v[j];
            else { u32x2 w; w.x = cvt_pk_bf16(v[j][0], v[j][1]); w.y = cvt_pk_bf16(v[j][2], v[j][3]); *(u32x2*)(xob + (size_t)row * D + 256 * j + 4 * lane) = w; } }
    }
}
__device__ __forceinline__ void p_attn(Frame& F) {
    PHASE_PROLOGUE();
    const bf16* Q = WSP(bf16, WS_QK1); const bf16* Kt = Q + (size_t)M * D; const bf16* VT = WSP(bf16, WS_VT1); bf16* AO = WSP(bf16, WS_AO);
    const int r = lane & 31, hh = lane >> 5;
    const int pir = (r & 0x13) | ((r & 4) << 1) | ((r & 8) >> 1);
    for (int wu = F.bid * NWAVES + wave; wu < BATCH * 8 * (SEQ / 32); wu += F.G * NWAVES) {
        const int qb = wu & 127, bhd = wu >> 7, b = bhd >> 3, hd = bhd & 7;
        const size_t tok0 = (size_t)b * SEQ; const int q0 = 32 * qb;
        bf16x8 qf[8];
#pragma unroll
        for (int s = 0; s < 8; ++s) qf[s] = *(const bf16x8*)(Q + (tok0 + q0 + r) * D + hd * 128 + 16 * s + 8 * hh);
        f32x16 o[4];
#pragma unroll
        for (int et = 0; et < 4; ++et) o[et] = (f32x16){};
        float carry = 1.f;
        bf16x8 kf[8];
        { const bf16* kp = Kt + ((size_t)bhd * SEQ + q0) * 128 + lane * 8;
#pragma unroll
          for (int s = 0; s < 8; ++s) kf[s] = *(const bf16x8*)(kp + 512 * s); }
        for (int kb = qb; kb >= 0; --kb) {
            const int k0 = 32 * kb;
            f32x16 st = {};
#pragma unroll
            for (int s = 0; s < 8; ++s) st = __builtin_amdgcn_mfma_f32_32x32x16_bf16(kf[s], qf[s], st, 0, 0, 0);
            if (kb > 0) { const bf16* kp = Kt + ((size_t)bhd * SEQ + k0 - 32) * 128 + lane * 8;
#pragma unroll
                for (int s = 0; s < 8; ++s) kf[s] = *(const bf16x8*)(kp + 512 * s); }
            float bt[16], omb[16];
#pragma unroll
            for (int g = 0; g < 16; ++g) { const float z = __builtin_amdgcn_fmed3f(st[g], -80.f, 80.f); const float ez = __builtin_amdgcn_exp2f(-z); bt[g] = __builtin_amdgcn_rcpf(1.f + ez); omb[g] = ez * bt[g]; }
            if (kb == qb) {
#pragma unroll
                for (int g = 0; g < 16; ++g) { const int kl = 16 * (g >> 3) + 8 * hh + (g & 7); if (kl >= r) { bt[g] = 0.f; omb[g] = 1.f; } } }
            float rA = omb[0], rB = omb[8];
#pragma unroll
            for (int g = 1; g < 8; ++g) { rA *= omb[g]; rB *= omb[g + 8]; }
            const float pA = __shfl_xor(rA, 32), pB = __shfl_xor(rB, 32);
            float a[16];
            float run = carry * (hh ? 1.f : pB);
#pragma unroll
            for (int g = 15; g >= 8; --g) { a[g] = bt[g] * run; run *= omb[g]; }
            run = carry * (rB * pB) * (hh ? 1.f : pA);
#pragma unroll
            for (int g = 7; g >= 0; --g) { a[g] = bt[g] * run; run *= omb[g]; }
            carry *= (rA * rB) * (pA * pB);
#pragma unroll
            for (int s = 0; s < 2; ++s) {
                u32x4 pw; pw.x = cvt_pk_bf16(a[8 * s + 0], a[8 * s + 1]); pw.y = cvt_pk_bf16(a[8 * s + 2], a[8 * s + 3]); pw.z = cvt_pk_bf16(a[8 * s + 4], a[8 * s + 5]); pw.w = cvt_pk_bf16(a[8 * s + 6], a[8 * s + 7]);
#pragma unroll
                for (int et = 0; et < 4; ++et) { const bf16x8 vf = *(const bf16x8*)(VT + ((size_t)bhd * SEQ + k0) * 128 + ((s * 4 + et) * 64 + lane) * 8);
                    o[et] = __builtin_amdgcn_mfma_f32_32x32x16_bf16(__builtin_bit_cast(bf16x8, pw), vf, o[et], 0, 0, 0); }
            }
            if (__all(carry < SB_EXIT)) break;
        }
#pragma unroll
        for (int et = 0; et < 4; ++et)
#pragma unroll
            for (int g = 0; g < 16; ++g) ((unsigned char*)AO)[(tok0 + q0 + crow(g, hh)) * D + hd * 128 + 32 * et + r] = fp8_1(o[et][g] * (float)(1 << SH_MIX));
    }
}

#ifndef MOE_ALIGN_EPI
#define MOE_ALIGN_EPI 1
#endif
constexpr bool MOE_ALIGN = MOE_ALIGN_EPI != 0;
constexpr int AUX_T2E = AUX_OFF, AUX_TSTART = AUX_OFF + 1280, AUX_TAB = AUX_OFF + 1536, AUX_BIAS = AUX_OFF + 1536 + 10240;
static_assert(AUX_BIAS + 3072 <= AUX_OFF + AUX_BYTES, "AUX map");
__device__ __forceinline__ int build_tiles(Frame& F, const unsigned* cnt) {
    PHASE_PROLOGUE();
    LAS int* t2e = (LAS int*)(F.lds + AUX_T2E); LAS int* ts = (LAS int*)(F.lds + AUX_TSTART);
    if (tid < NE) t2e[288 + tid] = (int)cnt[64 * tid];
    __syncthreads();
    if (tid == 0) { int T = 0;
        for (int e = 0; e < NE; ++e) { ts[e] = T; const int n = (t2e[288 + e] + 255) >> 8; for (int i = 0; i < n; ++i) t2e[T + i] = e; T += n; }
        ts[NE] = T; }
    __syncthreads();
    return ts[NE];
}

#ifdef ONLY_PHASE
#define IN(k) ((k) == ONLY_PHASE)
#else
#define IN(k) (lo <= (k) && (k) < hi)
#endif
#define SEAM(k) do { if (IN(k) && IN((k) + 1)) xcd_barrier(bar); } while (0)
template <int layer>
__device__ __forceinline__ void layer_phases(Frame& F, const XcdBarrier& bar, const int lo, const int hi) {
    LAS unsigned char* ring = F.lds + RING_OFF;
    {
        constexpr int pb = layer ? 12 : 5;
        if constexpr (layer == 1) {
            if (IN(10)) { PHASE_PROLOGUE();
                { pg8::Gemm g{WSP(bf16, WS_X2B), WSP(bf16, WS_WIN1), M, 2 * D, D, 0, 0};
                  pg8::StaticOrder S; S.init(M / 256, 2 * D / 256, F.G, F.bid, nullptr);
                  pg8::EpiQK E{WSP(bf16, WS_QK1), WSP(bf16, WS_QK1) + (size_t)M * D, QSCALE1};
                  pg8::gemm_phase<pg8::EpiQK, false, true>(ring, g, S, E, nullptr, F.wave); }
                { pg8::Gemm g{WSP(bf16, WS_WIN1) + (size_t)2 * D * D, WSP(bf16, WS_X2B), D, M, D, 0, 0};
                  pg8::StaticOrder S; S.init(D / 256, M / 256, F.G, F.bid, nullptr);
                  pg8::EpiVT E{WSP(bf16, WS_VT1)};
                  pg8::gemm_phase<pg8::EpiVT, false, true>(ring, g, S, E, nullptr, F.wave); }
            } SEAM(10);
            if (IN(11)) { p_attn(F);
            } SEAM(11);
        }
        if (IN(pb)) { PHASE_PROLOGUE();
            pg8::Gemm g{layer ? WSP(bf16, WS_AO) : WSP(bf16, WS_MIX), WSP(bf16, layer ? WS_WOUT1 : WS_WOUT0), M, D, D, 0, SCL_OUT, ctl + CW_RDY + 2048 + 64 * layer};
            pg8::StaticOrder S; S.init(M / 256, D / 256, F.G, F.bid, nullptr);
            pg8::EpiResid<true> E{layer ? (const void*)WSP(bf16, WS_X2B) : (const void*)WSP(bf16, WS_XBF), WSP(bf16, WS_YPRE)};
            pg8::gemm_phase<pg8::EpiResid<true>, false, true, true, pg8::NoRide, pg8::StaticOrder, 1>(ring, g, S, E, nullptr, F.wave);
        }
        if (IN(pb) && IN(pb + 1) && !F.xok) xcd_barrier(bar);
        if (IN(pb + 1)) { p_router(F, layer); } SEAM(pb + 1);
        if (IN(pb + 2)) { PHASE_PROLOGUE(); const unsigned* cnt = ctl + CW_CNT + layer * 2048;
            const int T = build_tiles(F, cnt);
            const LAS int* t2e = (const LAS int*)(F.lds + AUX_T2E); const LAS int* ts = (const LAS int*)(F.lds + AUX_TSTART);
            LAS int* rowtab = (LAS int*)(F.lds + AUX_TAB);
            pg8::XcdOrder S; S.init(T, 2 * FF / 256, F.G, F.bid, 0, t2e);
            const int* rowtok = WSP(int, WS_ROWTOK);
            { const int nu = S.count();
#pragma unroll 5
              for (int en = tid; en < nu * 256; en += 512) { pg8::Unit u; S.next(en >> 8, u); const int idx = (u.pm - ts[u.e]) * 256 + (en & 255); const bool ok = idx < t2e[288 + u.e];
                  rowtab[en] = rowtok[u.e * CAP + (ok ? idx : 0)] >> 2; } }
            __syncthreads();
            constexpr bool F8 = MOE_FP8[layer];
            pg8::Gemm g{F8 ? WSP(void, WS_X1F8) : WSP(void, WS_X1B), WSP(bf16, layer ? WS_WUP1 : WS_WUP0), T * 256, 2 * FF, D, (size_t)2 * FF * D * (F8 ? 1 : 2), SCL_UP, ctl + CW_RDY + 512 * layer};
            pg8::EpiUp<F8> E{P->in[layer ? 25 : 13], WSP(void, WS_ACT), (LAS float*)(F.lds + AUX_BIAS)};
            if constexpr (layer == 0) { MoeRide R; R.P = P; R.ws = ws; R.base = MOE_ITEMS_L; R.limit = MOE_ITEMS; R.ok = false;
                pg8::gemm_phase<pg8::EpiUp<F8>, true, MOE_ALIGN, F8, MoeRide, pg8::XcdOrder, 1>(ring, g, S, E, rowtab, F.wave, R); }
            else pg8::gemm_phase<pg8::EpiUp<F8>, true, MOE_ALIGN, F8, pg8::NoRide, pg8::XcdOrder, 1>(ring, g, S, E, rowtab, F.wave);
        }
        if (IN(pb + 2) && IN(pb + 3) && !F.xok) xcd_barrier(bar);
        if (IN(pb + 3)) { PHASE_PROLOGUE(); const unsigned* cnt = ctl + CW_CNT + layer * 2048;
            int T; if (IN(pb + 2)) { __syncthreads(); T = ((const LAS int*)(F.lds + AUX_TSTART))[NE]; } else T = build_tiles(F, cnt);
            const LAS int* t2e = (const LAS int*)(F.lds + AUX_T2E); const LAS int* ts = (const LAS int*)(F.lds + AUX_TSTART);
            LAS int* ttok = (LAS int*)(F.lds + AUX_TAB); LAS float* tgate = (LAS float*)(F.lds + AUX_TAB + 5 * 1024);
            pg8::XcdOrder S; S.init(T, D / 256, F.G, F.bid, 2 * FF / 256, t2e);
            const int* rowtok = WSP(int, WS_ROWTOK); const float* rowgate = WSP(float, WS_ROWGATE);
            { const int nu = S.count();
#pragma unroll 3
              for (int en = tid; en < nu * 256; en += 512) { pg8::Unit u; S.next(en >> 8, u); const int idx = (u.pm - ts[u.e]) * 256 + (en & 255); const bool ok = idx < t2e[288 + u.e];
                  ttok[en] = ok ? rowtok[u.e * CAP + idx] : -1; tgate[en] = ok ? rowgate[u.e * CAP + idx] : 0.f; } }
            __syncthreads();
            constexpr bool F8 = MOE_FP8[layer];
            pg8::Gemm g{WSP(bf16, WS_ACT), WSP(bf16, layer ? WS_WDN1 : WS_WDN0), T * 256, D, FF, (size_t)D * FF * (F8 ? 1 : 2), SCL_DN, ctl + CW_RDY + 512 * layer};
            pg8::EpiDown E{P->in[layer ? 27 : 15], WSP(bf16, WS_YSLOT), ttok, tgate, (LAS float*)(F.lds + AUX_BIAS)};
            if constexpr (layer == 0) { MoeRide R; R.P = P; R.ws = ws; R.base = MOE_ITEMS_L + T * 64; R.limit = MOE_ITEMS; R.ok = false;
                pg8::gemm_phase<pg8::EpiDown, false, MOE_ALIGN, F8, MoeRide, pg8::XcdOrder, 2, 2 * FF / 256>(ring, g, S, E, nullptr, F.wave, R); }
            else pg8::gemm_phase<pg8::EpiDown, false, MOE_ALIGN, F8, pg8::NoRide, pg8::XcdOrder, 2, 2 * FF / 256>(ring, g, S, E, nullptr, F.wave);
        } SEAM(pb + 3);
        if (IN(pb + 4)) { p_combine(F, layer); }
        if constexpr (layer == 0) SEAM(pb + 4);
    }
}
#undef IN
#undef SEAM
__global__ void __launch_bounds__(NWAVES * 64, 2) mega(Params Pk) {
    extern __shared__ __attribute__((aligned(16))) unsigned char lds_raw[];
    Frame F; F.lds = (LAS unsigned char*)lds_raw; F.G = gridDim.x; F.bid = blockIdx.x; F.wave = __builtin_amdgcn_readfirstlane(threadIdx.x >> 6); F.xok = 0;
    volatile LAS unsigned* MISC = (volatile LAS unsigned*)(F.lds + LCTL_OFF);
    if (threadIdx.x < 256) MISC[threadIdx.x] = 0u;
    __syncthreads();
    XcdBarrier bar = xcd_barrier_post((unsigned*)(Pk.ws + WS_CTL) + CW_BAR + Pk.li * XCD_BAR_WORDS, MISC + 8);
    const int lo = Pk.ph_lo, hi = Pk.ph_hi;
#ifdef ONLY_PHASE
#define IN(k) ((k) == ONLY_PHASE)
#else
#define IN(k) (lo <= (k) && (k) < hi)
#endif
#define SEAM(k) do { if (IN(k) && IN((k) + 1)) xcd_barrier(bar); } while (0)
    LAS unsigned char* ring = F.lds + RING_OFF;

    if (IN(0)) { p0_prep(F); } SEAM(0);
    if (IN(0) && IN(1)) { const unsigned* barw = (const unsigned*)(Pk.ws + WS_CTL) + CW_BAR + Pk.li * XCD_BAR_WORDS; bool even = true;
        for (int j = 0; j < 16; ++j) { const unsigned c = __builtin_nontemporal_load(barw + XB_XCNT(j)); even = even && (c == (j < 8 ? (unsigned)F.G / 8u : 0u)); }
        if (even && (F.G & 7) == 0) { F.bid = (int)(MISC[10] * 8u + MISC[11]); F.xok = 1; } }

    if (IN(1)) { PHASE_PROLOGUE();
        pg8::Gemm g{WSP(bf16, WS_XBF), WSP(bf16, WS_WIN0), M, L0N, D, 0, 0};
        pg8::StaticOrder S; S.init(M / 256, L0N / 256, F.G, F.bid, nullptr);
        pg8::EpiInProj0 E{WSP(bf16, WS_Q0), WSP(bf16, WS_K0), WSP(bf16, WS_V0), WSP(bf16, WS_SG), WSP(bf16, WS_U), WSP(float, WS_ROPE)};
        pg8::gemm_phase<pg8::EpiInProj0, false, true>(ring, g, S, E, nullptr, F.wave);
        if (F.bid >= 128) moe_convert3(F, CONV_A0 + CONV_P2 + (F.bid - 128) * CONV_C1 + F.wave, CONV_C1 / 8, 8, MOE_ITEMS_L);
    } SEAM(1);

    if (IN(2)) { for (int u = F.bid; u < 256 + 1024; u += F.G) { if (u < 256) p2_conv_unit(F, u); else p2_kv_unit(F, u - 256, CONV_A0 + (u - 256) * 8 + F.wave); } } SEAM(2);
    if (IN(3)) { p2_scan(F); } SEAM(3);
    if (IN(4)) { for (int wu = F.bid * NWAVES + F.wave; wu < 2048; wu += F.G * NWAVES) p2_ret_wave(F, wu); } SEAM(4);

    layer_phases<0>(F, bar, lo, hi);
    layer_phases<1>(F, bar, lo, hi);
#undef IN
#undef SEAM
}
static void launch_mega(const Params& base, int lo, int hi, int li, int grid, hipStream_t stream) {
    Params p = base; p.ph_lo = lo; p.ph_hi = hi; p.li = li; p.pad = 0;
    hipLaunchKernelGGL(mega, dim3(grid), dim3(NWAVES * 64), LDS_BYTES, stream, p);
}
extern "C" void kernel_launch(void* const* d_in, const int* in_sizes, int n_in, void* d_out, int out_size, void* d_ws, size_t ws_size, hipStream_t stream) {
    static int grid = 0;
    if (grid == 0) {
        if (n_in != 30 || ws_size < WS_END || out_size != M * D) { fprintf(stderr, "kernel_launch: unexpected shapes n_in=%d ws=%zu out=%d\n", n_in, ws_size, out_size); grid = -1; return; }
        int dev = 0, cus = 0, per_cu = 0;
        if (hipGetDevice(&dev) != hipSuccess || hipDeviceGetAttribute(&cus, hipDeviceAttributeMultiprocessorCount, dev) != hipSuccess) { grid = -1; return; }
        if (hipFuncSetAttribute((const void*)mega, hipFuncAttributeMaxDynamicSharedMemorySize, LDS_BYTES) != hipSuccess) { fprintf(stderr, "kernel_launch: hipFuncSetAttribute failed\n"); grid = -1; return; }
        if (hipOccupancyMaxActiveBlocksPerMultiprocessor(&per_cu, (const void*)mega, NWAVES * 64, LDS_BYTES) != hipSuccess || per_cu < 1) { fprintf(stderr, "kernel_launch: occupancy query says %d\n", per_cu); (void)hipGetLastError(); grid = -1; return; }
        grid = cus;
        if (grid != 256) { fprintf(stderr, "kernel_launch: built for 256 CUs, device has %d\n", cus); grid = -1; return; }
    }
    if (grid < 0) return;
    (void)hipMemsetAsync((char*)d_ws + WS_CTL, 0, 1 * MiB, stream);
    Params a{};
    for (int i = 0; i < 30; ++i) a.in[i] = (const float*)d_in[i];
    a.out = (float*)d_out; a.ws = (unsigned char*)d_ws;
    launch_mega(a, 0, 17, 0, grid, stream);
}
```

```cpp
#include <hip/hip_runtime.h>
#include <cstdint>
#include <cstdio>

typedef unsigned short bf16;
#define LAS __attribute__((address_space(3)))
#define GAS __attribute__((address_space(1)))
typedef short bf16x8 __attribute__((ext_vector_type(8)));
typedef float f32x4 __attribute__((ext_vector_type(4)));
typedef float f32x2 __attribute__((ext_vector_type(2)));
typedef float f32x16 __attribute__((ext_vector_type(16)));
typedef unsigned u32x4 __attribute__((ext_vector_type(4)));
typedef unsigned u32x2 __attribute__((ext_vector_type(2)));
typedef int v4i __attribute__((ext_vector_type(4)));
typedef int v8i __attribute__((ext_vector_type(8)));

__device__ __forceinline__ float bf2f(bf16 v) { return __uint_as_float(((unsigned)v) << 16); }
__device__ __forceinline__ unsigned f2bf(float f) { unsigned u = __float_as_uint(f); return (u + 0x7fffu + ((u >> 16) & 1u)) >> 16; }
__device__ __forceinline__ unsigned pk2(float lo, float hi) { return f2bf(lo) | (f2bf(hi) << 16); }
typedef __bf16 bf16x2_t __attribute__((ext_vector_type(2)));
__device__ __forceinline__ unsigned cvt_pk_bf16(float lo, float hi) { const f32x2 v = {lo, hi}; const bf16x2_t b = __builtin_convertvector(v, bf16x2_t); return __builtin_bit_cast(unsigned, b); }
__device__ __forceinline__ float sigmoidf_(float x) { return __builtin_amdgcn_rcpf(1.f + __builtin_amdgcn_exp2f(-1.4426950408889634f * x)); }
template <int CTRL> __device__ __forceinline__ float dpp_mov(float v) { return __builtin_bit_cast(float, __builtin_amdgcn_update_dpp(0, __builtin_bit_cast(int, v), CTRL, 0xF, 0xF, true)); }
__device__ __forceinline__ float row16_sum(float v) { v += dpp_mov<0xB1>(v); v += dpp_mov<0x4E>(v); v += dpp_mov<0x141>(v); v += dpp_mov<0x140>(v); return v; }
__device__ __forceinline__ float lane_bcast(float v, int l) { return __builtin_bit_cast(float, __builtin_amdgcn_readlane(__builtin_bit_cast(int, v), l)); }
__device__ __forceinline__ float wave_sum(float v) { v = row16_sum(v); return (lane_bcast(v, 0) + lane_bcast(v, 16)) + (lane_bcast(v, 32) + lane_bcast(v, 48)); }
__device__ __forceinline__ float half32_sum(float v) { v = row16_sum(v); return v + __shfl_xor(v, 16); }

__device__ __forceinline__ unsigned pk4_fp8(float a, float b, float c, float d) {
    a = __builtin_amdgcn_fmed3f(a, -448.f, 448.f); b = __builtin_amdgcn_fmed3f(b, -448.f, 448.f); c = __builtin_amdgcn_fmed3f(c, -448.f, 448.f); d = __builtin_amdgcn_fmed3f(d, -448.f, 448.f);
    int w = 0; w = __builtin_amdgcn_cvt_pk_fp8_f32(a, b, w, false); w = __builtin_amdgcn_cvt_pk_fp8_f32(c, d, w, true); return (unsigned)w; }
__device__ __forceinline__ unsigned pk4_fp8_inrange(float a, float b, float c, float d) {
    int w = 0; w = __builtin_amdgcn_cvt_pk_fp8_f32(a, b, w, false); w = __builtin_amdgcn_cvt_pk_fp8_f32(c, d, w, true); return (unsigned)w; }
__device__ __forceinline__ f32x4 swiglu4(const f32x4 g, const f32x4 l, const float s) {
    f32x4 a, e, r, b;
#pragma unroll
    for (int j = 0; j < 4; ++j) { a[j] = __builtin_amdgcn_fmed3f(g[j], -3.0e38f, 7.f); b[j] = __builtin_amdgcn_fmed3f(l[j], -7.f, 7.f); }
    const f32x4 x = a * (-1.702f * 1.4426950408889634f);
#pragma unroll
    for (int j = 0; j < 4; ++j) e[j] = __builtin_amdgcn_exp2f(x[j]);
    const f32x4 d = e + 1.f;
#pragma unroll
    for (int j = 0; j < 4; ++j) r[j] = __builtin_amdgcn_rcpf(d[j]);
    const f32x4 t = b * s + s;
    return (a * r) * t;
}
#ifndef MOE_FP8_L0
#define MOE_FP8_L0 1
#endif
#ifndef MOE_FP8_L1
#define MOE_FP8_L1 1
#endif
constexpr bool MOE_FP8[2] = {MOE_FP8_L0 != 0, MOE_FP8_L1 != 0};
#ifndef YSLOT_FP8
#define YSLOT_FP8 1
#endif
constexpr bool YS8 = YSLOT_FP8 != 0; constexpr int SH_Y = 4;
constexpr int SH_WUP = 6, SH_WDN = 6, SH_ACT = 2;
constexpr int SCL_UP = 0x01010101 * (127 - SH_WUP / 2), SCL_DN = 0x01010101 * (127 - (SH_WDN + SH_ACT) / 2);
static_assert(SH_WUP % 2 == 0 && (SH_WDN + SH_ACT) % 2 == 0, "even total shifts");
constexpr int SH_WOUT = 6, SH_MIX = 4; constexpr int SCL_OUT = 0x01010101 * (127 - (SH_WOUT + SH_MIX) / 2);
static_assert((SH_WOUT + SH_MIX) % 2 == 0, "even total shift");
__device__ __forceinline__ unsigned char fp8_1(float a) { a = __builtin_amdgcn_fmed3f(a, -448.f, 448.f); return (unsigned char)(__builtin_amdgcn_cvt_pk_fp8_f32(a, a, 0, false) & 0xff); }
constexpr int D = 1024, BATCH = 4, SEQ = 4096, M = BATCH * SEQ;
constexpr int L0N = 2560, NE = 32, FF = 1024, CAP = 16384;
constexpr float LN_EPS = 1e-5f;
constexpr float ALPHA = 1.4142135623730951f;
constexpr float QSCALE1 = 0.08838834764831845f * 1.4426950408889634f;
constexpr float LN2F = 0.6931471805599453f;
constexpr float SB_EXIT = 7.174648e-43f;

constexpr size_t MiB = 1ull << 20;
constexpr size_t WS_CTL = 0;
constexpr size_t WS_WIN0 = 1 * MiB, WS_WOUT0 = 6 * MiB, WS_WIN1 = 8 * MiB, WS_WOUT1 = 14 * MiB;
constexpr size_t WS_WUP0 = 16 * MiB, WS_WUP1 = 144 * MiB, WS_WDN0 = 272 * MiB, WS_WDN1 = 336 * MiB;
constexpr size_t WS_ROPE = 400 * MiB;
constexpr size_t WS_RWT = 401 * MiB;
constexpr size_t WS_X1F8 = 402 * MiB;
constexpr size_t WS_X1 = 402 * MiB, WS_X1B = 466 * MiB, WS_X2 = 498 * MiB, WS_X2B = 562 * MiB, WS_YPRE = 594 * MiB;
constexpr size_t WS_ROWTOK = 658 * MiB, WS_ROWGATE = 660 * MiB;
constexpr size_t WS_S = 664 * MiB;
constexpr size_t WS_Q0 = WS_S, WS_K0 = WS_S + 8 * MiB, WS_V0 = WS_S + 16 * MiB, WS_SG = WS_S + 32 * MiB, WS_U = WS_S + 48 * MiB, WS_MIX = WS_S + 64 * MiB;
constexpr size_t WS_XBF = WS_S + 96 * MiB;
constexpr size_t WS_QK1 = WS_S, WS_VT1 = WS_S + 64 * MiB, WS_AO = WS_S + 96 * MiB;
constexpr size_t WS_ACT = WS_S;
constexpr size_t WS_YSLOT = 808 * MiB;
constexpr size_t WS_KV = 808 * MiB;
constexpr size_t WS_RT = 840 * MiB;
constexpr size_t WS_HBUF = 808 * MiB;
constexpr size_t WS_END = 1024 * MiB;
constexpr int CW_CNT = 1024, CW_BAR = 8192, CW_RDY = 131072;

namespace pg8 {
constexpr int BM = 256, BK = 64, HALF = 128, HTB = HALF * BK * 2, STAGE_BYTES = 8 * HTB, NXCD = 8, WGM = 8;
__host__ __device__ __forceinline__ int lds_byte(int r, int c) { const int st = (r >> 4) * 2 + (c >> 5), rr = r & 15, cc = c & 31, ob = rr * 64 + cc * 2; return st * 1024 + (ob ^ (((ob >> 9) & 1) << 5)); }
__host__ __device__ __forceinline__ void stage_rc(int b, int& R, int& C) { const int st = b / 1024, sb = b % 1024, swz = sb ^ (((sb >> 9) & 1) << 5); R = (st >> 1) * 16 + swz / 64; C = (st & 1) * 32 + (swz % 64) / 2; }
__host__ __device__ __forceinline__ int perm32(int rho) { const int n = rho >> 4, i = rho & 15; return 8 * (i >> 2) + 4 * n + (i & 3); }

struct Unit { int pm, pn, e; };
struct Gemm { const void* A; const void* Bt; int M, N, K; size_t estride; int scl; unsigned* rdy; };

struct StaticOrder {
    int nM, nN, nwg, G, c; const LAS int* t2e;
    __device__ void init(int nM_, int nN_, int G_, int c_, const LAS int* t2e_) { nM = nM_; nN = nN_; nwg = nM * nN; G = G_; c = c_; t2e = t2e_; }
    __device__ int count() const { return (nwg - c + G - 1) / G; }
    __device__ int ord(int i) const { return (int)((long)i * G + c); }
    __device__ bool next(int i, Unit& u) const {
        const long L = (long)i * G + c; if (L >= nwg) return false;
        int wgid = (int)L; { const int q = nwg / NXCD, r = nwg % NXCD, xcd = wgid % NXCD, off = wgid / NXCD; wgid = (xcd < r ? xcd * (q + 1) : r * (q + 1) + (xcd - r) * q) + off; }
        const int nig = WGM * nN, gid = wgid / nig, fm = gid * WGM, gsz = (nM - fm) < WGM ? (nM - fm) : WGM;
        u.pm = fm + ((wgid % nig) % gsz); u.pn = (wgid % nig) / gsz; u.e = t2e ? t2e[u.pm] : 0; return true;
    }
};

#ifndef WGM_X
#define WGM_X 2
#endif
#ifndef WGM_XD
#define WGM_XD 2
#endif
struct XcdOrder {
    int nN, T0, ntx, k, per, nloc; const LAS int* t2e;
    __device__ void init(int nM, int nN_, int G_, int c_, int prevN, const LAS int* t2e_) { nN = nN_; t2e = t2e_; per = G_ / NXCD;
        const int x = c_ % NXCD, q = nM / NXCD, r = nM % NXCD; ntx = q + (x < r ? 1 : 0); T0 = x * q + (x < r ? x : r); nloc = ntx * nN;
        k = (c_ / NXCD - (ntx * prevN) % per + per) % per; }
    __device__ int count() const { return nloc > k ? (nloc - k + per - 1) / per : 0; }
    __device__ int ord(int i) const { return T0 * nN + i * per + k; }
    __device__ bool next(int i, Unit& u) const { const int j = i * per + k; if (j >= nloc) return false;
        const int WX = nN >= 8 ? WGM_X : WGM_XD; const int nig = WX * nN, fm = (j / nig) * WX, gsz = (ntx - fm) < WX ? (ntx - fm) : WX, w = j % nig;
        u.pm = T0 + fm + w % gsz; u.pn = w / gsz; u.e = t2e[u.pm]; return true; }
};
__device__ __forceinline__ unsigned flow_peek(const unsigned* w) { return (unsigned)__builtin_amdgcn_readfirstlane((int)__hip_atomic_load(w, __ATOMIC_RELAXED, __HIP_MEMORY_SCOPE_AGENT)); }
__device__ __forceinline__ void flow_wait(const unsigned* w, unsigned need) { while (flow_peek(w) < need) __builtin_amdgcn_s_sleep(4); }
__device__ __forceinline__ void flow_wait_wg(const unsigned* w, unsigned need, int wave) { if (wave == 0) { while (flow_peek(w) < need) __builtin_amdgcn_s_sleep(8); } __builtin_amdgcn_s_barrier(); }

__device__ __forceinline__ void mfma_f8(f32x4& acc, const v8i a, const v8i b, const int scl) {
    asm volatile("s_nop 1\n\tv_mfma_scale_f32_16x16x128_f8f6f4 %0, %1, %2, %0, %3, %3 op_sel_hi:[0,0,0]" : "+v"(acc) : "v"(a), "v"(b), "v"(scl));
}
template <class E, class = void> struct has_ldsbias { static constexpr bool v = false; };
template <class E> struct has_ldsbias<E, decltype((void)E::LDSBIAS)> { static constexpr bool v = E::LDSBIAS; };
template <class E, class = void> struct has_accbias { static constexpr bool v = false; };
template <class E> struct has_accbias<E, decltype((void)E::ACCBIAS)> { static constexpr bool v = E::ACCBIAS; };
struct NoRide { __device__ __forceinline__ void begin(int, int, int) {} __device__ __forceinline__ void end(int) {} };
template <class Epi, bool GATHER, bool ALIGN_EPI, bool FP8 = false, class Ride = NoRide, class Ord = StaticOrder, int FLOW = 0, int FLOW_NEED = 0>
__device__ __forceinline__ void gemm_phase(LAS unsigned char* lds, const Gemm g, const Ord& S, const Epi& E, const LAS int* rowtab, const int wave_id, Ride ride = Ride()) {
    int lane_ = (int)__builtin_amdgcn_mbcnt_hi(~0u, __builtin_amdgcn_mbcnt_lo(~0u, 0u)); asm volatile("" : "+v"(lane_));
    const int lane = lane_, wid = wave_id, tid = wid * 64 + lane, wr = wid >> 2, wc = wid & 3, fr = lane & 15, fq = lane >> 4;
    const int K = g.K, rowb = K * (FP8 ? 1 : 2), nt = rowb / 128;
    const size_t kstep = 128;
    const size_t hstep = (size_t)HALF * rowb;
    const size_t tstep = 2 * hstep;
    const int scl_w = g.scl; (void)scl_w;
    unsigned voffB[2], vc[2][2], vn[2][2];
#pragma unroll
    for (int i = 0; i < 2; ++i) { int R, C; stage_rc(tid * 16 + i * 8192, R, C); const int Rb = Epi::PERM ? ((R & ~31) + perm32(R & 31)) : R;
        voffB[i] = (unsigned)(Rb * rowb + C * 2);
        vc[0][i] = (unsigned)(R * rowb + C * 2); vc[1][i] = vc[0][i] + (unsigned)hstep; vn[0][i] = vc[0][i]; vn[1][i] = vc[1][i]; }
    const unsigned ldsw = (unsigned)wid * 1024u;
    const int aoff = lds_byte(wr * 64 + fr, fq * 8), boff = lds_byte(wc * 32 + fr, fq * 8);
#define PG8_SA(b, h) (((b) * 2 + (h)) * HTB)
#define PG8_SB(b, h) ((4 + (b) * 2 + (h)) * HTB)
#define PG8_STAGE(bufoff, gbase, voff) do { _Pragma("unroll") for (int _i = 0; _i < 2; ++_i) \
        __builtin_amdgcn_global_load_lds((const unsigned*)((const char*)(gbase) + (voff)[_i]), (LAS unsigned*)(lds + (bufoff) + ldsw + _i * 8192), 16, 0, 0); } while (0)
#define PG8_LDA(dst, b, h) do { _Pragma("unroll") for (int m = 0; m < 4; ++m) _Pragma("unroll") for (int k = 0; k < 2; ++k) dst[m][k] = *(const LAS bf16x8*)(lds + PG8_SA(b, h) + aoff + m * 2048 + k * 1024); } while (0)
#define PG8_LDB(dst, b, h) do { _Pragma("unroll") for (int n = 0; n < 2; ++n) _Pragma("unroll") for (int k = 0; k < 2; ++k) dst[n][k] = *(const LAS bf16x8*)(lds + PG8_SB(b, h) + boff + n * 2048 + k * 1024); } while (0)
#define PG8_CAT(x0, x1) __builtin_shufflevector(__builtin_bit_cast(v4i, x0), __builtin_bit_cast(v4i, x1), 0, 1, 2, 3, 4, 5, 6, 7)
#define PG8_MMA(ai, bj, At, Bt) do { __builtin_amdgcn_s_setprio(1); if constexpr (FP8) { _Pragma("unroll") for (int m = 0; m < 4; ++m) _Pragma("unroll") for (int n = 0; n < 2; ++n) \
        mfma_f8(acc[ai][bj][m][n], PG8_CAT(Bt[n][0], Bt[n][1]), PG8_CAT(At[m][0], At[m][1]), scl_w); } else { \
        _Pragma("unroll") for (int m = 0; m < 4; ++m) _Pragma("unroll") for (int n = 0; n < 2; ++n) _Pragma("unroll") for (int k = 0; k < 2; ++k) \
        acc[ai][bj][m][n] = __builtin_amdgcn_mfma_f32_16x16x32_bf16(Bt[n][k], At[m][k], acc[ai][bj][m][n], 0, 0, 0); } __builtin_amdgcn_s_setprio(0); } while (0)
#define PG8_WAIT_V(n) asm volatile("s_waitcnt vmcnt(" #n ")" ::: "memory")
#define PG8_WAIT_L(n) asm volatile("s_waitcnt lgkmcnt(" #n ")" ::: "memory")
#define PG8_BAR __builtin_amdgcn_s_barrier()
#define PG8_SCHED __builtin_amdgcn_sched_barrier(0)
#define PG8_ROWOFF(dst, slot) do { if constexpr (GATHER) { _Pragma("unroll") for (int _i = 0; _i < 2; ++_i) { int _R, _C; stage_rc(tid * 16 + _i * 8192, _R, _C); _Pragma("unroll") for (int _h = 0; _h < 2; ++_h) \
        dst[_h][_i] = (unsigned)rowtab[(slot) * 256 + _h * 128 + _R] * (unsigned)rowb + (unsigned)(_C * 2); } } } while (0)
    Unit cur, nxt; int ui = 0;
    if (!S.next(0, cur)) return;
    int pub_pm = -1; (void)pub_pm;
    if constexpr (FLOW == 2) { flow_wait(g.rdy + cur.pm, FLOW_NEED); if (S.next(1, nxt)) flow_wait(g.rdy + nxt.pm, FLOW_NEED); }
    if constexpr (has_ldsbias<Epi>::v) { if (wid < 4) __builtin_amdgcn_global_load_lds((const unsigned*)(E.bias(cur) + wid * 64 + lane), (LAS unsigned*)(E.bl + wid * 64), 4, 0, 0); }
    f32x4 acc[2][2][4][2];
    if constexpr (has_accbias<Epi>::v) { asm volatile("s_waitcnt vmcnt(0)" ::: "memory"); __builtin_amdgcn_s_barrier(); E.init(acc, 0, wc, fq); }
    else {
#pragma unroll
    for (int a = 0; a < 2; ++a)
#pragma unroll
        for (int b = 0; b < 2; ++b)
#pragma unroll
            for (int m = 0; m < 4; ++m)
#pragma unroll
                for (int n = 0; n < 2; ++n) acc[a][b][m][n] = (f32x4){0.f, 0.f, 0.f, 0.f}; }
    bf16x8 At[4][2], B0[2][2], B1[2][2];
    PG8_ROWOFF(vc, 0);
    const char* cA = GATHER ? (const char*)g.A : (const char*)g.A + (size_t)cur.pm * tstep;
    const char* cB = (const char*)g.Bt + (size_t)cur.e * g.estride + (size_t)cur.pn * tstep;
    PG8_STAGE(PG8_SB(0, 0), cB, voffB); PG8_STAGE(PG8_SB(0, 1), cB + hstep, voffB); PG8_STAGE(PG8_SA(0, 0), cA, vc[0]); PG8_STAGE(PG8_SA(0, 1), cA, vc[1]);
    if (wr == 1) PG8_BAR;
    PG8_WAIT_V(2); PG8_BAR;
    PG8_STAGE(PG8_SB(1, 0), cB + kstep, voffB); PG8_STAGE(PG8_SA(1, 0), cA + kstep, vc[0]); PG8_STAGE(PG8_SB(1, 1), cB + hstep + kstep, voffB);
    PG8_WAIT_V(6); PG8_BAR;
    for (;;) {
        const bool has_next = S.next(ui + 1, nxt);
        const char* nA = GATHER ? cA : (has_next ? (const char*)g.A + (size_t)nxt.pm * tstep : cA);
        const char* nB = has_next ? (const char*)g.Bt + (size_t)nxt.e * g.estride + (size_t)nxt.pn * tstep : cB;
        if constexpr (has_ldsbias<Epi>::v) { if (has_next && wid < 4) __builtin_amdgcn_global_load_lds((const unsigned*)(E.bias(nxt) + wid * 64 + lane), (LAS unsigned*)(E.bl + ((ui + 1) % 3) * 256 + wid * 64), 4, 0, 0); }
        if constexpr (GATHER) { if (has_next) { PG8_ROWOFF(vn, ui + 1); } else {
#pragma unroll
            for (int h = 0; h < 2; ++h)
#pragma unroll
                for (int i = 0; i < 2; ++i) vn[h][i] = vc[h][i]; } }
#pragma nounroll
        for (int t = 0; t < nt; t += 2) {
            const bool last = (t == nt - 2);
            const char* a1 = cA + (size_t)(t + 1) * kstep;
            const char* a2 = last ? nA : cA + (size_t)(t + 2) * kstep; const char* b2 = last ? nB : cB + (size_t)(t + 2) * kstep;
            const char* a3 = a2 + kstep; const char* b3 = b2 + kstep;
            unsigned w0[2], w1[2];
#pragma unroll
            for (int i = 0; i < 2; ++i) { w0[i] = (GATHER && last) ? vn[0][i] : vc[0][i]; w1[i] = (GATHER && last) ? vn[1][i] : vc[1][i]; }
            PG8_LDB(B0, 0, 0); PG8_LDB(B1, 0, 1); PG8_SCHED; PG8_LDA(At, 0, 0); PG8_STAGE(PG8_SA(1, 1), a1, vc[1]);
            PG8_WAIT_V(8); PG8_WAIT_L(0); PG8_BAR; PG8_MMA(0, 0, At, B0); PG8_MMA(0, 1, At, B1); PG8_BAR; PG8_SCHED;
            PG8_LDA(At, 0, 1); PG8_STAGE(PG8_SB(0, 0), b2, voffB); PG8_STAGE(PG8_SB(0, 1), b2 + hstep, voffB); PG8_STAGE(PG8_SA(0, 0), a2, w0);
            PG8_WAIT_V(8); PG8_WAIT_L(0); PG8_BAR; PG8_MMA(1, 0, At, B0); PG8_MMA(1, 1, At, B1); PG8_BAR; PG8_SCHED;
            PG8_LDB(B0, 1, 0); PG8_LDB(B1, 1, 1); PG8_SCHED; PG8_LDA(At, 1, 0); PG8_STAGE(PG8_SA(0, 1), a2, w1);
            PG8_WAIT_V(8); PG8_WAIT_L(0); PG8_BAR; PG8_MMA(0, 0, At, B0); PG8_MMA(0, 1, At, B1); PG8_BAR; PG8_SCHED;
            PG8_LDA(At, 1, 1); PG8_STAGE(PG8_SB(1, 0), b3, voffB); PG8_STAGE(PG8_SB(1, 1), b3 + hstep, voffB); PG8_STAGE(PG8_SA(1, 0), a3, w0);
            PG8_WAIT_V(8); PG8_WAIT_L(0); PG8_BAR; PG8_MMA(1, 0, At, B0); PG8_MMA(1, 1, At, B1); PG8_BAR; PG8_SCHED;
        }
        if constexpr (ALIGN_EPI) { if (wr == 0) PG8_BAR; }
        if constexpr (FLOW == 1) { if (pub_pm >= 0 && wid == 0 && lane == 0) __hip_atomic_fetch_add(g.rdy + pub_pm, 1u, __ATOMIC_RELAXED, __HIP_MEMORY_SCOPE_AGENT); }
        ride.begin(S.ord(ui), wid, lane);
        Unit nn; bool has2 = false; unsigned rv = 0; (void)has2; (void)rv;
        if constexpr (FLOW == 2) { has2 = S.next(ui + 2, nn); if (has2) rv = __hip_atomic_load(g.rdy + nn.pm, __ATOMIC_RELAXED, __HIP_MEMORY_SCOPE_AGENT); }
        if constexpr (FP8) asm volatile("s_nop 15\n\ts_nop 15" ::: "memory");
        E(acc, cur, ui, wr, wc, fr, fq);
        ride.end(lane);
        if constexpr (FLOW == 2) { if (has2 && (unsigned)__builtin_amdgcn_readfirstlane((int)rv) < (unsigned)FLOW_NEED) flow_wait(g.rdy + nn.pm, FLOW_NEED); }
        if constexpr (FLOW == 1) pub_pm = cur.pm;
        if (!has_next) break;
        if constexpr (has_accbias<Epi>::v) E.init(acc, ui + 1, wc, fq);
        else {
#pragma unroll
        for (int a = 0; a < 2; ++a)
#pragma unroll
            for (int b = 0; b < 2; ++b)
#pragma unroll
                for (int m = 0; m < 4; ++m)
#pragma unroll
                    for (int n = 0; n < 2; ++n) acc[a][b][m][n] = (f32x4){0.f, 0.f, 0.f, 0.f}; }
        cur = nxt; cA = nA; cB = nB; ++ui;
        if constexpr (GATHER) {
#pragma unroll
            for (int h = 0; h < 2; ++h)
#pragma unroll
                for (int i = 0; i < 2; ++i) vc[h][i] = vn[h][i]; }
        if constexpr (ALIGN_EPI) { if (wr == 1) PG8_BAR; }
    }
    PG8_WAIT_V(0);
    if constexpr (!ALIGN_EPI) { if (wr == 0) PG8_BAR; }
    PG8_BAR;
    if constexpr (FLOW == 1) { if (pub_pm >= 0 && wid == 0 && lane == 0) __hip_atomic_fetch_add(g.rdy + pub_pm, 1u, __ATOMIC_RELAXED, __HIP_MEMORY_SCOPE_AGENT); }
#undef PG8_SA
#undef PG8_SB
#undef PG8_STAGE
#undef PG8_LDA
#undef PG8_LDB
#undef PG8_MMA
#undef PG8_CAT
#undef PG8_WAIT_V
#undef PG8_WAIT_L
#undef PG8_BAR
#undef PG8_SCHED
#undef PG8_ROWOFF
}
}
namespace pg8 {
struct EpiInProj0 {
    static constexpr bool PERM = true;
    bf16 *Q0, *K0, *V0, *SG, *U; const float* rope;
    __device__ __forceinline__ void operator()(const f32x4 (&acc)[2][2][4][2], const Unit& u, int, int wr, int wc, int fr, int fq) const {
        const int row0 = u.pm * BM + wr * 64 + fr;
        if (u.pn < 2) {
            bf16* dst = u.pn == 0 ? Q0 : K0; const float sc = u.pn == 0 ? 1.f : 0.125f;
            f32x4 nc0, nc1, ns0, ns1;
            { const float* cp = rope + (row0 & (SEQ - 1)) * 32 + 8 * fq; const float* sp = cp + SEQ * 32; nc0 = *(const f32x4*)cp; nc1 = *(const f32x4*)(cp + 4); ns0 = *(const f32x4*)sp; ns1 = *(const f32x4*)(sp + 4); }
#pragma unroll
            for (int ai = 0; ai < 2; ++ai)
#pragma unroll
                for (int m = 0; m < 4; ++m) {
                    const int row = row0 + ai * HALF + m * 16;
                    const f32x4 c0 = nc0, c1 = nc1, s0 = ns0, s1 = ns1;
                    { const int gi = ai * 4 + m + 1;
                      if (gi < 8) { const int nrow = row0 + (gi >> 2) * HALF + (gi & 3) * 16; const float* cp = rope + (nrow & (SEQ - 1)) * 32 + 8 * fq; const float* sp = cp + SEQ * 32;
                          nc0 = *(const f32x4*)cp; nc1 = *(const f32x4*)(cp + 4); ns0 = *(const f32x4*)sp; ns1 = *(const f32x4*)(sp + 4); } }
                    const f32x4 a0 = acc[ai][0][m][0], a1 = acc[ai][0][m][1], b0 = acc[ai][1][m][0], b1 = acc[ai][1][m][1];
                    const f32x4 o10 = (a0 * c0 - b0 * s0) * sc, o11 = (a1 * c1 - b1 * s1) * sc, o20 = (b0 * c0 + a0 * s0) * sc, o21 = (b1 * c1 + a1 * s1) * sc;
                    bf16* p = dst + (size_t)row * 256 + 64 * wc + 8 * fq;
                    u32x4 w; w.x = cvt_pk_bf16(o10[0], o10[1]); w.y = cvt_pk_bf16(o10[2], o10[3]); w.z = cvt_pk_bf16(o11[0], o11[1]); w.w = cvt_pk_bf16(o11[2], o11[3]);
                    *(u32x4*)p = w;
                    w.x = cvt_pk_bf16(o20[0], o20[1]); w.y = cvt_pk_bf16(o20[2], o20[3]); w.z = cvt_pk_bf16(o21[0], o21[1]); w.w = cvt_pk_bf16(o21[2], o21[3]);
                    *(u32x4*)(p + 32) = w;
                    asm volatile("" ::: "memory");
                }
        } else if (u.pn < 6) {
            const bool isg = u.pn >= 4; bf16* dst = isg ? SG : V0; const int colb = 256 * ((u.pn - 2) & 1) + 32 * wc + 8 * fq;
#pragma unroll
            for (int ai = 0; ai < 2; ++ai)
#pragma unroll
                for (int m = 0; m < 4; ++m) {
                    const int row = row0 + ai * HALF + m * 16;
#pragma unroll
                    for (int bj = 0; bj < 2; ++bj) {
                        f32x4 v0 = acc[ai][bj][m][0], v1 = acc[ai][bj][m][1];
                        if (isg) {
#pragma unroll
                            for (int j = 0; j < 4; ++j) { v0[j] = v0[j] * sigmoidf_(v0[j]); v1[j] = v1[j] * sigmoidf_(v1[j]); } }
                        u32x4 w; w.x = cvt_pk_bf16(v0[0], v0[1]); w.y = cvt_pk_bf16(v0[2], v0[3]); w.z = cvt_pk_bf16(v1[0], v1[1]); w.w = cvt_pk_bf16(v1[2], v1[3]);
                        *(u32x4*)(dst + (size_t)row * 512 + colb + bj * HALF) = w;
                    }
                }
        } else {
            const int ch0 = 128 * (u.pn - 6) + 32 * wc + 8 * fq;
#pragma unroll
            for (int ai = 0; ai < 2; ++ai)
#pragma unroll
                for (int m = 0; m < 4; ++m) {
                    const int row = row0 + ai * HALF + m * 16;
                    f32x4 v0 = acc[ai][0][m][0], v1 = acc[ai][0][m][1]; const f32x4 g0 = acc[ai][1][m][0], g1 = acc[ai][1][m][1];
#pragma unroll
                    for (int j = 0; j < 4; ++j) { v0[j] = v0[j] * sigmoidf_(g0[j]); v1[j] = v1[j] * sigmoidf_(g1[j]); }
                    u32x4 w; w.x = cvt_pk_bf16(v0[0], v0[1]); w.y = cvt_pk_bf16(v0[2], v0[3]); w.z = cvt_pk_bf16(v1[0], v1[1]); w.w = cvt_pk_bf16(v1[2], v1[3]);
                    *(u32x4*)(U + (size_t)row * 512 + ch0) = w;
                }
        }
    }
};
template <bool RB> struct EpiResid {
    static constexpr bool PERM = true;
    const void* xres; bf16* y;
    struct RG { u32x4 w[2]; f32x4 x[2][2]; };
    __device__ __forceinline__ void load(RG& g, size_t off) const {
#pragma unroll
        for (int bj = 0; bj < 2; ++bj) {
            if constexpr (RB) g.w[bj] = *(const u32x4*)((const bf16*)xres + off + bj * HALF);
            else { g.x[bj][0] = *(const f32x4*)((const float*)xres + off + bj * HALF); g.x[bj][1] = *(const f32x4*)((const float*)xres + off + bj * HALF + 4); } }
    }
    __device__ __forceinline__ void operator()(const f32x4 (&acc)[2][2][4][2], const Unit& u, int, int wr, int wc, int fr, int fq) const {
        const int row0 = u.pm * BM + wr * 64 + fr, col0 = u.pn * BM + wc * 32 + 8 * fq;
        RG cur, nx; load(cur, (size_t)row0 * D + col0);
#pragma unroll
        for (int ai = 0; ai < 2; ++ai)
#pragma unroll
            for (int m = 0; m < 4; ++m) { const size_t off = (size_t)(row0 + ai * HALF + m * 16) * D + col0;
                const int gi = ai * 4 + m + 1;
                if (RB && gi < 8) load(nx, (size_t)(row0 + (gi >> 2) * HALF + (gi & 3) * 16) * D + col0);
#pragma unroll
                for (int bj = 0; bj < 2; ++bj) { f32x4 x0, x1;
                    if constexpr (RB) { const u32x4 w = cur.w[bj];
                        x0 = (f32x4){__uint_as_float(w.x << 16), __uint_as_float(w.x & 0xffff0000u), __uint_as_float(w.y << 16), __uint_as_float(w.y & 0xffff0000u)};
                        x1 = (f32x4){__uint_as_float(w.z << 16), __uint_as_float(w.z & 0xffff0000u), __uint_as_float(w.w << 16), __uint_as_float(w.w & 0xffff0000u)}; }
                    else { x0 = cur.x[bj][0]; x1 = cur.x[bj][1]; }
                    const f32x4 v0 = x0 * ALPHA + acc[ai][bj][m][0], v1 = x1 * ALPHA + acc[ai][bj][m][1];
                    u32x4 w; w.x = cvt_pk_bf16(v0[0], v0[1]); w.y = cvt_pk_bf16(v0[2], v0[3]); w.z = cvt_pk_bf16(v1[0], v1[1]); w.w = cvt_pk_bf16(v1[2], v1[3]);
                    *(u32x4*)(y + off + bj * HALF) = w; }
                asm volatile("" ::: "memory");
                if constexpr (RB) cur = nx; else if (gi < 8) load(cur, (size_t)(row0 + (gi >> 2) * HALF + (gi & 3) * 16) * D + col0); }
    }
};
template <bool F8> struct EpiUp {
    static constexpr bool PERM = true, LDSBIAS = true, ACCBIAS = true;
    const float* bup; void* act; LAS float* bl;
    __device__ __forceinline__ const float* bias(const Unit& u) const { return bup + (size_t)u.e * 2 * FF + 256 * u.pn; }
    __device__ __forceinline__ void init(f32x4 (&acc)[2][2][4][2], int ui, int wc, int fq) const {
        const LAS float* bp = bl + (ui % 3) * 256 + 64 * wc + 16 * fq;
        const f32x4 q0 = *(const LAS f32x4*)bp, q1 = *(const LAS f32x4*)(bp + 4), q2 = *(const LAS f32x4*)(bp + 8), q3 = *(const LAS f32x4*)(bp + 12);
        const f32x4 bg0 = {q0[0], q0[2], q1[0], q1[2]}, bl0 = {q0[1], q0[3], q1[1], q1[3]}, bg1 = {q2[0], q2[2], q3[0], q3[2]}, bl1 = {q2[1], q2[3], q3[1], q3[3]};
#pragma unroll
        for (int ai = 0; ai < 2; ++ai)
#pragma unroll
            for (int m = 0; m < 4; ++m) { acc[ai][0][m][0] = bg0; acc[ai][0][m][1] = bg1; acc[ai][1][m][0] = bl0; acc[ai][1][m][1] = bl1; }
    }
    __device__ __forceinline__ void operator()(const f32x4 (&acc)[2][2][4][2], const Unit& u, int ui, int wr, int wc, int fr, int fq) const {
        const int ch0 = 128 * u.pn + 32 * wc + 8 * fq;
        const int row0 = u.pm * BM + wr * 64 + fr;
#pragma unroll
        for (int ai = 0; ai < 2; ++ai)
#pragma unroll
            for (int m = 0; m < 4; ++m) {
                const int row = row0 + ai * HALF + m * 16;
                const f32x4 g0 = swiglu4(acc[ai][0][m][0], acc[ai][1][m][0], F8 ? (float)(1 << SH_ACT) : 1.f), g1 = swiglu4(acc[ai][0][m][1], acc[ai][1][m][1], F8 ? (float)(1 << SH_ACT) : 1.f);
                if constexpr (F8) { u32x2 w; w.x = pk4_fp8_inrange(g0[0], g0[1], g0[2], g0[3]); w.y = pk4_fp8_inrange(g1[0], g1[1], g1[2], g1[3]);
                    *(u32x2*)((unsigned char*)act + (size_t)row * FF + ch0) = w; }
                else { u32x4 w; w.x = cvt_pk_bf16(g0[0], g0[1]); w.y = cvt_pk_bf16(g0[2], g0[3]); w.z = cvt_pk_bf16(g1[0], g1[1]); w.w = cvt_pk_bf16(g1[2], g1[3]);
                    *(u32x4*)((bf16*)act + (size_t)row * FF + ch0) = w; }
                asm volatile("" ::: "memory");
            }
    }
};
struct EpiDown {
    static constexpr bool PERM = true, LDSBIAS = true, ACCBIAS = true;
    const float* bdn; bf16* yslot; const LAS int* ttok; const LAS float* tgate; LAS float* bl;
    __device__ __forceinline__ const float* bias(const Unit& u) const { return bdn + (size_t)u.e * D + 256 * u.pn; }
    __device__ __forceinline__ void init(f32x4 (&acc)[2][2][4][2], int ui, int wc, int fq) const {
#pragma unroll
        for (int bj = 0; bj < 2; ++bj)
#pragma unroll
            for (int n = 0; n < 2; ++n) { const f32x4 bv = *(const LAS f32x4*)(bl + (ui % 3) * 256 + wc * 32 + 8 * fq + bj * HALF + 4 * n);
#pragma unroll
                for (int ai = 0; ai < 2; ++ai)
#pragma unroll
                    for (int m = 0; m < 4; ++m) acc[ai][bj][m][n] = bv; }
    }
    __device__ __forceinline__ void operator()(const f32x4 (&acc)[2][2][4][2], const Unit& u, int ui, int wr, int wc, int fr, int fq) const {
        const int col0 = u.pn * BM + wc * 32 + 8 * fq;
#pragma unroll
        for (int ai = 0; ai < 2; ++ai)
#pragma unroll
            for (int m = 0; m < 4; ++m) {
                const int r = ai * HALF + wr * 64 + m * 16 + fr; const int tok4 = ttok[ui * 256 + r]; const float gt = tgate[ui * 256 + r] * (YS8 ? (float)(1 << SH_Y) : 1.f);
                if (tok4 >= 0) {
#pragma unroll
                    for (int bj = 0; bj < 2; ++bj) { const f32x4 v0 = acc[ai][bj][m][0] * gt, v1 = acc[ai][bj][m][1] * gt;
                        if constexpr (YS8) { u32x2 w; w.x = pk4_fp8(v0[0], v0[1], v0[2], v0[3]); w.y = pk4_fp8(v1[0], v1[1], v1[2], v1[3]);
                            *(u32x2*)((unsigned char*)yslot + (size_t)tok4 * D + col0 + bj * HALF) = w; }
                        else { u32x4 w; w.x = cvt_pk_bf16(v0[0], v0[1]); w.y = cvt_pk_bf16(v0[2], v0[3]); w.z = cvt_pk_bf16(v1[0], v1[1]); w.w = cvt_pk_bf16(v1[2], v1[3]);
                            *(u32x4*)(yslot + (size_t)tok4 * D + col0 + bj * HALF) = w; } }
                }
                asm volatile("" ::: "memory");
            }
    }
};
struct EpiBf16 {
    static constexpr bool PERM = true;
    bf16* O; int ldc; int split_cols; size_t split_stride; float scale0;
    __device__ __forceinline__ void operator()(const f32x4 (&acc)[2][2][4][2], const Unit& u, int, int wr, int wc, int fr, int fq) const {
        const int row0 = u.pm * BM + wr * 64 + fr; int colt = u.pn * BM; bf16* base = O; float sc = 1.f;
        if (split_cols) { const int t = colt / split_cols; base += (size_t)t * split_stride; colt -= t * split_cols; if (t == 0) sc = scale0; }
        const int col0 = colt + wc * 32 + 8 * fq;
#pragma unroll
        for (int ai = 0; ai < 2; ++ai)
#pragma unroll
            for (int m = 0; m < 4; ++m) { bf16* rowp = base + (size_t)(row0 + ai * HALF + m * 16) * ldc + col0;
#pragma unroll
                for (int bj = 0; bj < 2; ++bj) { const f32x4 v0 = acc[ai][bj][m][0] * sc, v1 = acc[ai][bj][m][1] * sc;
                    u32x4 w; w.x = cvt_pk_bf16(v0[0], v0[1]); w.y = cvt_pk_bf16(v0[2], v0[3]); w.z = cvt_pk_bf16(v1[0], v1[1]); w.w = cvt_pk_bf16(v1[2], v1[3]);
                    *(u32x4*)(rowp + bj * HALF) = w; } }
    }
};
__device__ __forceinline__ int pi32(int r) { return (r & 0x13) | ((r & 4) << 1) | ((r & 8) >> 1); }
struct EpiQK {
    static constexpr bool PERM = true;
    bf16* Q; bf16* Kf; float qscale;
    __device__ __forceinline__ void operator()(const f32x4 (&acc)[2][2][4][2], const Unit& u, int, int wr, int wc, int fr, int fq) const {
        const int row0 = u.pm * BM + wr * 64 + fr; const bool isk = u.pn >= 4; const int colt = (u.pn & 3) * BM + wc * 32 + 8 * fq; const float sc = isk ? 1.f : qscale;
#pragma unroll
        for (int ai = 0; ai < 2; ++ai)
#pragma unroll
            for (int m = 0; m < 4; ++m) { const int row = row0 + ai * HALF + m * 16;
#pragma unroll
                for (int bj = 0; bj < 2; ++bj) { const f32x4 v0 = acc[ai][bj][m][0] * sc, v1 = acc[ai][bj][m][1] * sc; const int col = colt + bj * HALF;
                    u32x4 w; w.x = cvt_pk_bf16(v0[0], v0[1]); w.y = cvt_pk_bf16(v0[2], v0[3]); w.z = cvt_pk_bf16(v1[0], v1[1]); w.w = cvt_pk_bf16(v1[2], v1[3]);
                    if (isk) { const int b = row >> 12, t = row & (SEQ - 1), h = col >> 7, c16 = (col & 127) >> 3;
                        *(u32x4*)(Kf + ((size_t)(b * 8 + h) * SEQ + (t & ~31)) * 128 + ((c16 >> 1) * 64 + (c16 & 1) * 32 + pi32(t & 31)) * 8) = w; }
                    else *(u32x4*)(Q + (size_t)row * D + col) = w; } }
    }
};
struct EpiVT {
    static constexpr bool PERM = true;
    bf16* Vf;
    __device__ __forceinline__ void operator()(const f32x4 (&acc)[2][2][4][2], const Unit& u, int, int wr, int wc, int fr, int fq) const {
        const int row0 = u.pm * BM + wr * 64 + fr, colt = u.pn * BM + wc * 32 + 8 * fq;
#pragma unroll
        for (int ai = 0; ai < 2; ++ai)
#pragma unroll
            for (int m = 0; m < 4; ++m) { const int row = row0 + ai * HALF + m * 16, h = row >> 7, e = row & 127;
#pragma unroll
                for (int bj = 0; bj < 2; ++bj) { const f32x4 v0 = acc[ai][bj][m][0], v1 = acc[ai][bj][m][1]; const int tok = colt + bj * HALF, b = tok >> 12, t = tok & (SEQ - 1);
                    u32x4 w; w.x = cvt_pk_bf16(v0[0], v0[1]); w.y = cvt_pk_bf16(v0[2], v0[3]); w.z = cvt_pk_bf16(v1[0], v1[1]); w.w = cvt_pk_bf16(v1[2], v1[3]);
                    *(u32x4*)(Vf + ((size_t)(b * 8 + h) * SEQ + (t & ~31)) * 128 + ((((t >> 4) & 1) * 4 + (e >> 5)) * 64 + ((t >> 3) & 1) * 32 + (e & 31)) * 8) = w; } }
    }
};
}

typedef GAS unsigned gu32;
#define RLX_AGENT __ATOMIC_RELAXED, __HIP_MEMORY_SCOPE_AGENT
#define LDS_WAIT() asm volatile("s_waitcnt lgkmcnt(0)" ::: "memory")
#define VM_WAIT() asm volatile("s_waitcnt vmcnt(0)" ::: "memory")
#define XB_TMO      128
#define XB_XCNT(j)  (256  + 64 * (j))
#define XB_XSUB(j)  (1280 + 64 * (j))
#define XB_XGEN(j)  (2304 + 64 * (j))
#define XB_TOP      3328
#define XB_TOPGEN   3392
#define XCD_BAR_WORDS 3456
#define XB_SPIN_CAP (1u << 18)
__device__ __forceinline__ unsigned xb_ld(unsigned* p)              { return __hip_atomic_load(p, __ATOMIC_RELAXED, __HIP_MEMORY_SCOPE_AGENT); }
__device__ __forceinline__ unsigned xb_add(unsigned* p, unsigned v) { return __hip_atomic_fetch_add(p, v, __ATOMIC_RELAXED, __HIP_MEMORY_SCOPE_AGENT); }
__device__ __forceinline__ unsigned xb_xcc_id() { return (unsigned)__builtin_amdgcn_s_getreg((3 << 11) | 20) & 0xFu; }
#define XB_SPIN(cond, bar) do { unsigned _sp = 0; while (cond) { __builtin_amdgcn_s_sleep(1); \
    if ((++_sp & 255u) == 0u) { if (xb_ld(&(bar)[XB_TMO])) break; if (_sp > XB_SPIN_CAP) { atomicAdd(&(bar)[XB_TMO], 1u); break; } } } } while (0)
struct XcdBarrier { unsigned* bar; unsigned x; volatile LAS unsigned* st; };
__device__ __forceinline__ XcdBarrier xcd_barrier_post(unsigned* bar, volatile LAS unsigned* st) {
    XcdBarrier b; b.bar = bar; b.x = xb_xcc_id(); b.st = st;
    if (threadIdx.x == 0) { const unsigned rank = xb_add(&bar[XB_XCNT(b.x)], 1u); st[2] = rank; st[3] = b.x; }
    return b;
}
__device__ __forceinline__ void xcd_barrier_complete(unsigned* bar, unsigned x, unsigned& nloc, unsigned& nx) {
    const unsigned G = gridDim.x * gridDim.y * gridDim.z;
    unsigned sum, cnt, mine, sp = 0u;
    for (;;) {
        sum = 0u; cnt = 0u; mine = 0u;
#pragma unroll
        for (unsigned j = 0; j < 16; ++j) { const unsigned c = xb_ld(&bar[XB_XCNT(j)]); sum += c; cnt += (c > 0u) ? 1u : 0u; mine = (j == x) ? c : mine; }
        if (sum == G) break;
        __builtin_amdgcn_s_sleep(1);
        if ((++sp & 255u) == 0u) { if (xb_ld(&bar[XB_TMO])) break; if (sp > XB_SPIN_CAP) { atomicAdd(&bar[XB_TMO], 1u); break; } }
    }
    nloc = mine > 0u ? mine : 1u; nx = cnt > 0u ? cnt : 1u;
}
template <bool WARM = true>
__device__ __forceinline__ void xcd_barrier(const XcdBarrier& b) {
    asm volatile("s_waitcnt vmcnt(0)" ::: "memory");
    __syncthreads();
    unsigned warm = 0u;
    if (WARM && threadIdx.x >= 64 && threadIdx.x < 448) { const unsigned long long pc = (unsigned long long)__builtin_amdgcn_s_getpc();
        warm = *(const volatile GAS unsigned*)((const GAS unsigned*)(pc + (unsigned long long)((b.st[2] & 31u) * 1536u + (threadIdx.x - 64u) * 4u))); }
    if (threadIdx.x == 0) {
        unsigned* bar = b.bar;
        __builtin_amdgcn_s_waitcnt(0);
        unsigned nloc = b.st[0], nx = b.st[1];
        if (nloc == 0u) { xcd_barrier_complete(bar, b.x, nloc, nx); b.st[0] = nloc; b.st[1] = nx; }
        const unsigned old = xb_add(&bar[XB_XSUB(b.x)], 1u);
        const unsigned gen = old / nloc;
        if (old + 1u == (gen + 1u) * nloc) {
            __builtin_amdgcn_fence(__ATOMIC_RELEASE, "agent");
            asm volatile("s_waitcnt vmcnt(0)" ::: "memory");
            const unsigned og = xb_add(&bar[XB_TOP], 1u);
            const unsigned tg = og / nx;
            if (og + 1u == (tg + 1u) * nx) xb_add(&bar[XB_TOPGEN], 1u);
            else XB_SPIN(xb_ld(&bar[XB_TOPGEN]) == tg, bar);
            __builtin_amdgcn_fence(__ATOMIC_ACQUIRE, "agent");
            xb_add(&bar[XB_XGEN(b.x)], 1u);
            asm volatile("s_waitcnt vmcnt(0)" ::: "memory");
        } else {
            XB_SPIN(xb_ld(&bar[XB_XGEN(b.x)]) == gen, bar);
            __builtin_amdgcn_fence(__ATOMIC_ACQUIRE, "agent");
            asm volatile("s_waitcnt vmcnt(0)" ::: "memory");
        }
    }
    __syncthreads();
    (void)warm;
}
constexpr int NWAVES = 8;
constexpr int RING_OFF = 0, RING_BYTES = 131072;
constexpr int AUX_OFF = 131072, AUX_BYTES = 15360;
constexpr int LCTL_OFF = AUX_OFF + AUX_BYTES;
constexpr int LDS_BYTES = 147456;
static_assert(LCTL_OFF + 1024 == LDS_BYTES, "LDS map");

struct Params { const float* in[30]; float* out; unsigned char* ws; int ph_lo, ph_hi, li, pad; };

struct Frame { LAS unsigned char* lds; int G, bid, wave, xok; };
typedef const __attribute__((address_space(4))) Params* KParams;
__device__ __forceinline__ KParams kargs() { KParams p = (KParams)__builtin_amdgcn_kernarg_segment_ptr(); asm volatile("" : "+s"(p)); return p; }
#define PHASE_PROLOGUE() int lane_ = (int)__builtin_amdgcn_mbcnt_hi(~0u, __builtin_amdgcn_mbcnt_lo(~0u, 0u)); asm volatile("" : "+v"(lane_)); const int lane = lane_, wave = F.wave, tid = wave * 64 + lane; \
    KParams P = kargs(); unsigned char* const ws = P->ws; unsigned* const ctl = (unsigned*)(ws + WS_CTL); (void)tid; (void)ctl
#define WSP(T, off) ((T*)(ws + (off)))

__device__ __forceinline__ int rowmap(int kind, int n) {
    if (kind == 1) {
        if (n < 512) { const int base = n & 256, r = n & 255, h = r >> 6, bj = (r >> 5) & 1, dd = r & 31; return base + 128 * bj + 32 * h + dd; }
        if (n < 1536) return n;
        if (n < 2048) { const int i = n - 1536; return 1536 + 256 * (i >> 7) + (i & 127); }
        const int i = n - 2048; return 1536 + 256 * (i >> 7) + 128 + (i & 127);
    }
    if (kind == 2) { const int ch = n >> 1; return 256 * (ch >> 7) + 128 * (n & 1) + (ch & 127); }
    return n;
}
__device__ __forceinline__ void p0_item(const float* W, int K, int N, bf16* WT, int kind, LAS float* scr, int kb, int nb, int lane) {
    const int k0 = 64 * kb, n0 = 64 * nb;
    f32x4 v[16];
#pragma unroll
    for (int i = 0; i < 16; ++i) v[i] = *(const f32x4*)(W + (size_t)(k0 + 4 * i + (lane >> 4)) * N + n0 + 4 * (lane & 15));
#pragma unroll
    for (int i = 0; i < 16; ++i) { LAS float* s = scr + (4 * i + (lane >> 4)) * 65 + 4 * (lane & 15); s[0] = v[i][0]; s[1] = v[i][1]; s[2] = v[i][2]; s[3] = v[i][3]; }
    LDS_WAIT(); asm volatile("" ::: "memory");
    const int c = lane & 7;
#pragma unroll
    for (int j = 0; j < 8; ++j) { const int n = (lane >> 3) + 8 * j; const LAS float* s = scr + (8 * c) * 65 + n;
        u32x4 o; o.x = pk2(s[0], s[65]); o.y = pk2(s[130], s[195]); o.z = pk2(s[260], s[325]); o.w = pk2(s[390], s[455]);
        *(u32x4*)(WT + (size_t)rowmap(kind, n0 + n) * K + k0 + 8 * c) = o; }
    LDS_WAIT(); asm volatile("" ::: "memory");
}
constexpr int I_UP = NE * 16 * 32, I_DN = NE * 16 * 16, MOE_ITEMS_L = I_UP + I_DN, MOE_ITEMS = 2 * MOE_ITEMS_L;
struct ItemD { const float* W; unsigned char* WT; int N, kind, sh, k0, n0; };
__device__ __forceinline__ ItemD moe_item_desc(KParams P, unsigned char* ws, int idx) {
    ItemD d; const int l = idx >= MOE_ITEMS_L; int r = idx - l * MOE_ITEMS_L;
    if (r < I_UP) { const int e = r >> 9, q = r & 511; d.W = P->in[l ? 24 : 12] + (size_t)e * D * 2 * FF; d.WT = ws + (l ? WS_WUP1 : WS_WUP0) + (size_t)e * 2 * FF * D; d.N = 2 * FF; d.kind = 2; d.sh = SH_WUP; d.k0 = 64 * (q >> 5); d.n0 = 64 * (q & 31); }
    else { r -= I_UP; const int e = r >> 8, q = r & 255; d.W = P->in[l ? 26 : 14] + (size_t)e * FF * D; d.WT = ws + (l ? WS_WDN1 : WS_WDN0) + (size_t)e * D * FF; d.N = D; d.kind = 0; d.sh = SH_WDN; d.k0 = 64 * (q >> 4); d.n0 = 64 * (q & 15); }
    return d;
}
__device__ __forceinline__ void item8_load(f32x4 (&v)[16], const ItemD& d, int lane) {
#pragma unroll
    for (int i = 0; i < 16; ++i) v[i] = __builtin_nontemporal_load((const f32x4*)(d.W + (size_t)(d.k0 + 16 * (lane >> 4) + i) * d.N + d.n0 + 4 * (lane & 15)));
}
__device__ __forceinline__ void item8_finish(const f32x4 (&v)[16], const ItemD& d, int lane) {
    const float sc = (float)(1 << d.sh);
#pragma unroll
    for (int j = 0; j < 4; ++j) { u32x4 w;
        w.x = pk4_fp8(v[0][j] * sc, v[1][j] * sc, v[2][j] * sc, v[3][j] * sc); w.y = pk4_fp8(v[4][j] * sc, v[5][j] * sc, v[6][j] * sc, v[7][j] * sc);
        w.z = pk4_fp8(v[8][j] * sc, v[9][j] * sc, v[10][j] * sc, v[11][j] * sc); w.w = pk4_fp8(v[12][j] * sc, v[13][j] * sc, v[14][j] * sc, v[15][j] * sc);
        *(u32x4*)(d.WT + (size_t)rowmap(d.kind, d.n0 + 4 * (lane & 15) + j) * 1024 + d.k0 + 16 * (lane >> 4)) = w; }
}
struct MoeRide {
    KParams P; unsigned char* ws; int base, limit; ItemD d; f32x4 v[16]; bool ok;
    __device__ __forceinline__ void begin(int L, int w, int lane) { asm volatile("" : "+v"(lane));
        const int idx = base + 8 * L + w; ok = idx < limit; d = moe_item_desc(P, ws, ok ? idx : limit - 1);
        if (ok) item8_load(v, d, lane); else {
#pragma unroll
            for (int i = 0; i < 16; ++i) v[i] = (f32x4){0.f, 0.f, 0.f, 0.f}; } }
    __device__ __forceinline__ void end(int lane) { if (ok) item8_finish(v, d, lane); }
};
__device__ __forceinline__ void moe_convert(Frame& F, int first, int n, int stride, int limit) {
    PHASE_PROLOGUE();
    if (n > 0 && first + (n - 1) * stride >= limit) n = (limit - first + stride - 1) / stride;
    if (n <= 0) return;
    f32x4 vc[16], vn[16];
    ItemD dc = moe_item_desc(P, ws, first), dn = dc;
    item8_load(vc, dc, lane);
    for (int k = 0; k < n; ++k) {
        const bool more = k + 1 < n;
        if (more) { dn = moe_item_desc(P, ws, first + (k + 1) * stride); item8_load(vn, dn, lane); }
        item8_finish(vc, dc, lane);
        if (more) { dc = dn;
#pragma unroll
            for (int i = 0; i < 16; ++i) vc[i] = vn[i]; }
    }
}
__device__ __forceinline__ void p0_item8(const float* W, int K, int N, unsigned char* WT, int kind, int sh, LAS float* scr, int kb, int nb, int lane) {
    const int k0 = 64 * kb, n0 = 64 * nb;
    f32x4 v[16];
#pragma unroll
    for (int i = 0; i < 16; ++i) v[i] = *(const f32x4*)(W + (size_t)(k0 + 4 * i + (lane >> 4)) * N + n0 + 4 * (lane & 15));
#pragma unroll
    for (int i = 0; i < 16; ++i) { LAS float* s = scr + (4 * i + (lane >> 4)) * 65 + 4 * (lane & 15); s[0] = v[i][0]; s[1] = v[i][1]; s[2] = v[i][2]; s[3] = v[i][3]; }
    LDS_WAIT(); asm volatile("" ::: "memory");
    const float sc = (float)(1 << sh); const LAS float* s = scr + lane;
    unsigned char* o = WT + (size_t)rowmap(kind, n0 + lane) * K + k0;
#pragma unroll
    for (int j = 0; j < 4; ++j) { u32x4 w;
        w.x = pk4_fp8(s[(16 * j + 0) * 65] * sc, s[(16 * j + 1) * 65] * sc, s[(16 * j + 2) * 65] * sc, s[(16 * j + 3) * 65] * sc);
        w.y = pk4_fp8(s[(16 * j + 4) * 65] * sc, s[(16 * j + 5) * 65] * sc, s[(16 * j + 6) * 65] * sc, s[(16 * j + 7) * 65] * sc);
        w.z = pk4_fp8(s[(16 * j + 8) * 65] * sc, s[(16 * j + 9) * 65] * sc, s[(16 * j + 10) * 65] * sc, s[(16 * j + 11) * 65] * sc);
        w.w = pk4_fp8(s[(16 * j + 12) * 65] * sc, s[(16 * j + 13) * 65] * sc, s[(16 * j + 14) * 65] * sc, s[(16 * j + 15) * 65] * sc);
        *(u32x4*)(o + 16 * j) = w; }
    LDS_WAIT(); asm volatile("" ::: "memory");
}
constexpr int CONV_C1 = 64, CONV_P2 = 1024 * 8, CONV_A0 = MOE_ITEMS_L - 128 * CONV_C1 - CONV_P2;
__device__ __forceinline__ void p0_prep(Frame& F) {
    PHASE_PROLOGUE();
    LAS float* scr = (LAS float*)(F.lds + wave * 16640);
    const int gw = F.bid * NWAVES + wave, NGW = F.G * NWAVES;
    constexpr int I_IN0 = 16 * 40, I_O = 16 * 16, I_IN1 = 16 * 48;
    constexpr int NITEMS = I_IN0 + 2 * I_O + I_IN1;
    for (int it = gw; it < NITEMS; it += NGW) {
        int r = it;
        if (r < I_IN0) { p0_item(P->in[1], D, L0N, WSP(bf16, WS_WIN0), 1, scr, r / 40, r % 40, lane); continue; } r -= I_IN0;
        if (r < I_O) { p0_item8(P->in[7], D, D, WSP(unsigned char, WS_WOUT0), 0, SH_WOUT, scr, r >> 4, r & 15, lane); continue; } r -= I_O;
        if (r < I_IN1) { p0_item(P->in[18], D, 3 * D, WSP(bf16, WS_WIN1), 0, scr, r / 48, r % 48, lane); continue; } r -= I_IN1;
        p0_item8(P->in[19], D, D, WSP(unsigned char, WS_WOUT1), 0, SH_WOUT, scr, r >> 4, r & 15, lane);
    }
    static_assert(MOE_FP8[0] && MOE_FP8[1], "the conversion schedule assumes fp8 expert weights in both layers");
    moe_convert(F, gw, (CONV_A0 - gw + NGW - 1) / NGW, NGW, CONV_A0);
    { const float* x = P->in[0]; bf16* xb = WSP(bf16, WS_XBF);
      for (int m = gw; m < M; m += 4 * NGW) {
          f32x4 v[4][4];
#pragma unroll
          for (int q = 0; q < 4; ++q) { const f32x4* xr = (const f32x4*)(x + (size_t)(m + q * NGW) * D) + lane;
#pragma unroll
              for (int j = 0; j < 4; ++j) v[q][j] = xr[64 * j]; }
#pragma unroll
          for (int q = 0; q < 4; ++q) { u32x2* o = (u32x2*)(xb + (size_t)(m + q * NGW) * D) + lane;
#pragma unroll
              for (int j = 0; j < 4; ++j) { u32x2 w; w.x = pk2(v[q][j][0], v[q][j][1]); w.y = pk2(v[q][j][2], v[q][j][3]); o[64 * j] = w; } } } }
    static_assert(M % (4 * 2048) == 0, "bf16(x) loop: rows per trip");
    { bf16* rwf = WSP(bf16, WS_RWT);
      for (int i = gw * 64 + lane; i < 2 * 64 * 64; i += NGW * 64) { const int l = i >> 12, s = (i >> 6) & 63, ln = i & 63, e = ln & 31, h = ln >> 5; const float* rw = P->in[l ? 22 : 10];
          u32x4 hi4, lo4; unsigned hw[8], lw[8];
#pragma unroll
          for (int j = 0; j < 8; ++j) { const float w = rw[(16 * s + 8 * h + j) * NE + e]; const unsigned hb = f2bf(w); hw[j] = hb; lw[j] = f2bf(w - __uint_as_float(hb << 16)); }
          hi4.x = hw[0] | (hw[1] << 16); hi4.y = hw[2] | (hw[3] << 16); hi4.z = hw[4] | (hw[5] << 16); hi4.w = hw[6] | (hw[7] << 16);
          lo4.x = lw[0] | (lw[1] << 16); lo4.y = lw[2] | (lw[3] << 16); lo4.z = lw[4] | (lw[5] << 16); lo4.w = lw[6] | (lw[7] << 16);
          *(u32x4*)(rwf + ((size_t)(l * 2 + 0) * 4096 + s * 64 + ln) * 8) = hi4; *(u32x4*)(rwf + ((size_t)(l * 2 + 1) * 4096 + s * 64 + ln) * 8) = lo4; } }
    { float* rope = WSP(float, WS_ROPE);
      for (int i = gw * 64 + lane; i < SEQ * 32; i += NGW * 64) { const int pos = i >> 5, d = i & 31;
          const float inv = powf(10000.f, -(float)d / 32.f); const float ang = (float)pos * inv; rope[i] = cosf(ang); rope[SEQ * 32 + i] = sinf(ang); } }
}

__device__ __forceinline__ int crow(int r, int hi) { return (r & 3) + 8 * (r >> 2) + 4 * hi; }
__device__ __forceinline__ float head_log2g(int hd) { return log2f(1.f - exp2f(-5.f - (float)hd)); }

__device__ __forceinline__ void p2_kv_unit(Frame& F, int unit, int item) {
    PHASE_PROLOGUE();
    ItemD cd = moe_item_desc(P, ws, item); f32x4 cv[16]; item8_load(cv, cd, lane);
    const int bh = unit >> 6, c = unit & 63, b = bh >> 2, hd = bh & 3, r = lane & 31, h = lane >> 5, et = wave >> 1, dt = wave & 1;
    const bf16* K0 = WSP(bf16, WS_K0); const bf16* V0 = WSP(bf16, WS_V0); float* KV = WSP(float, WS_KV);
    const float l2g = head_log2g(hd);
    const size_t row0 = (size_t)b * SEQ + 64 * c;
    f32x16 acc = {};
#pragma unroll
    for (int s = 0; s < 4; ++s) {
        bf16x8 a, bb;
#pragma unroll
        for (int j = 0; j < 8; ++j) { const int m = 16 * s + 8 * h + j;
            a[j] = (short)V0[(row0 + m) * 512 + hd * 128 + 32 * et + r];
            const float kz = bf2f(K0[(row0 + m) * 256 + hd * 64 + 32 * dt + r]) * __builtin_amdgcn_exp2f((float)(63 - m) * l2g);
            bb[j] = (short)f2bf(kz); }
        acc = __builtin_amdgcn_mfma_f32_32x32x16_bf16(a, bb, acc, 0, 0, 0);
    }
    float* o = KV + ((size_t)unit * 128 + 32 * et) * 64 + 32 * dt + r;
#pragma unroll
    for (int g = 0; g < 16; ++g) o[crow(g, h) * 64] = acc[g];
    item8_finish(cv, cd, lane);
}
__device__ __forceinline__ void p2_scan(Frame& F) {
    PHASE_PROLOGUE();
    const float* KV = WSP(float, WS_KV); bf16* RT = WSP(bf16, WS_RT);
    for (int gid = F.bid * 512 + tid; gid < 16 * 8192; gid += F.G * 512) {
        const int bh = gid >> 13, rem = gid & 8191; const float gc = exp2f(64.f * head_log2g(bh & 3));
        float R = 0.f;
        float kv[16], kn[16];
#pragma unroll
        for (int i = 0; i < 16; ++i) kv[i] = KV[((size_t)(bh * 64 + i)) * 8192 + rem];
#pragma unroll
        for (int c0 = 0; c0 < 64; c0 += 16) {
            if (c0 + 16 < 64) {
#pragma unroll
                for (int i = 0; i < 16; ++i) kn[i] = KV[((size_t)(bh * 64 + c0 + 16 + i)) * 8192 + rem]; }
#pragma unroll
            for (int i = 0; i < 16; ++i) { RT[((size_t)(bh * 64 + c0 + i)) * 8192 + rem] = (bf16)f2bf(R); R = gc * R + kv[i]; }
#pragma unroll
            for (int i = 0; i < 16; ++i) kv[i] = kn[i];
        }
    }
}
__device__ __forceinline__ void p2_ret_wave(Frame& F, int wu) {
    PHASE_PROLOGUE();
    const int unit = wu >> 1, nt = wu & 1, bh = unit >> 6, c = unit & 63, b = bh >> 2, hd = bh & 3, r = lane & 31, h = lane >> 5;
    const bf16* Q0 = WSP(bf16, WS_Q0); const bf16* K0 = WSP(bf16, WS_K0); const bf16* V0 = WSP(bf16, WS_V0); const bf16* SG = WSP(bf16, WS_SG); const bf16* RT = WSP(bf16, WS_RT);
    bf16* mix = WSP(bf16, WS_MIX); const float* gng = P->in[2];
    const float l2g = head_log2g(hd);
    const size_t row0 = (size_t)b * SEQ + 64 * c;
    bf16x8 qf[4], kf[2][4], rf[4][4];
#pragma unroll
    for (int s = 0; s < 4; ++s) qf[s] = *(const bf16x8*)(Q0 + (row0 + 32 * nt + r) * 256 + hd * 64 + 16 * s + 8 * h);
#pragma unroll
    for (int et = 0; et < 4; ++et)
#pragma unroll
        for (int s = 0; s < 4; ++s) rf[et][s] = *(const bf16x8*)(RT + ((size_t)unit * 128 + 32 * et + r) * 64 + 16 * s + 8 * h);
#pragma unroll
    for (int mt = 0; mt < 2; ++mt)
#pragma unroll
        for (int s = 0; s < 4; ++s) kf[mt][s] = *(const bf16x8*)(K0 + (row0 + 32 * mt + r) * 256 + hd * 64 + 16 * s + 8 * h);
    __builtin_amdgcn_sched_barrier(0);
    f32x16 o[4];
#pragma unroll
    for (int et = 0; et < 4; ++et) { o[et] = (f32x16){};
#pragma unroll
        for (int s = 0; s < 4; ++s) o[et] = __builtin_amdgcn_mfma_f32_32x32x16_bf16(qf[s], rf[et][s], o[et], 0, 0, 0); }
    __builtin_amdgcn_sched_barrier(0);
    bf16x8 va[4], vb[4];
#define P2C_VLOAD(dst, mt_, s_) do { _Pragma("unroll") for (int et = 0; et < 4; ++et) { _Pragma("unroll") for (int j = 0; j < 8; ++j) { \
        const int m = 32 * (mt_) + 16 * (s_) + 8 * (j >> 2) + 4 * h + (j & 3); dst[et][j] = (short)V0[(row0 + m) * 512 + hd * 128 + 32 * et + r]; } } } while (0)
    P2C_VLOAD(va, 0, 0);
#pragma unroll
    for (int g = 0; g < 16; ++g) { const float xi = __builtin_amdgcn_exp2f((float)(32 * nt + crow(g, h) + 1) * l2g);
#pragma unroll
        for (int et = 0; et < 4; ++et) o[et][g] *= xi; }
#pragma unroll
    for (int mt = 0; mt < 2; ++mt) {
        f32x16 st = {};
#pragma unroll
        for (int s = 0; s < 4; ++s) st = __builtin_amdgcn_mfma_f32_32x32x16_bf16(kf[mt][s], qf[s], st, 0, 0, 0);
#pragma unroll
        for (int g = 0; g < 16; ++g) { const int dist = (32 * nt + r) - (32 * mt + crow(g, h)); st[g] *= __builtin_amdgcn_exp2f(fabsf((float)dist) * l2g); }
#pragma unroll
        for (int s = 0; s < 2; ++s) {
            u32x4 pw; pw.x = cvt_pk_bf16(st[8 * s + 0], st[8 * s + 1]); pw.y = cvt_pk_bf16(st[8 * s + 2], st[8 * s + 3]); pw.z = cvt_pk_bf16(st[8 * s + 4], st[8 * s + 5]); pw.w = cvt_pk_bf16(st[8 * s + 6], st[8 * s + 7]);
            if (mt * 2 + s < 3) { P2C_VLOAD(vb, (mt * 2 + s + 1) >> 1, (mt * 2 + s + 1) & 1); }
            __builtin_amdgcn_sched_barrier(0);
#pragma unroll
            for (int et = 0; et < 4; ++et) o[et] = __builtin_amdgcn_mfma_f32_32x32x16_bf16(__builtin_bit_cast(bf16x8, pw), va[et], o[et], 0, 0, 0);
            __builtin_amdgcn_sched_barrier(0);
#pragma unroll
            for (int et = 0; et < 4; ++et) va[et] = vb[et];
        }
    }
#undef P2C_VLOAD
    float sgv[4][16], ggv[4];
#pragma unroll
    for (int et = 0; et < 4; ++et) { ggv[et] = gng[hd * 128 + 32 * et + r];
#pragma unroll
        for (int g = 0; g < 16; ++g) sgv[et][g] = bf2f(SG[(row0 + 32 * nt + crow(g, h)) * 512 + hd * 128 + 32 * et + r]); }
    __builtin_amdgcn_sched_barrier(0);
    float mu[16], rs[16];
#pragma unroll
    for (int g = 0; g < 16; ++g) { float a = (o[0][g] + o[1][g]) + (o[2][g] + o[3][g]), q = (o[0][g] * o[0][g] + o[1][g] * o[1][g]) + (o[2][g] * o[2][g] + o[3][g] * o[3][g]);
        a = half32_sum(a); q = half32_sum(q);
        mu[g] = a * (1.f / 128.f); rs[g] = rsqrtf(fmaxf(q * (1.f / 128.f) - mu[g] * mu[g], 0.f) + LN_EPS); }
#pragma unroll
    for (int et = 0; et < 4; ++et) {
#pragma unroll
        for (int g = 0; g < 16; ++g) { const size_t row = row0 + 32 * nt + crow(g, h);
            ((unsigned char*)mix)[row * D + hd * 128 + 32 * et + r] = fp8_1((o[et][g] - mu[g]) * rs[g] * ggv[et] * sgv[et][g] * (float)(1 << SH_MIX)); } }
}
__device__ __forceinline__ void p2_conv_unit(Frame& F, int u) {
    PHASE_PROLOGUE();
    const bf16* U = WSP(bf16, WS_U); bf16* mix = WSP(bf16, WS_MIX);
    const float* cw = P->in[3]; const float* cb = P->in[4]; const float* lg = P->in[5]; const float* lb = P->in[6];
    const int r0 = 64 * u, t0 = r0 & (SEQ - 1), ch = tid;
    LAS float* Y = (LAS float*)(F.lds + RING_OFF);
    float w[31];
#pragma unroll
    for (int j = 0; j < 31; ++j) w[j] = cw[j * 512 + ch];
    const float cbias = cb[ch];
    for (int q = 0; q < 2; ++q) {
        float val[62];
#pragma unroll
        for (int i = 0; i < 62; ++i) { const int rel = 32 * q + i - 30; const bool ok = t0 + rel >= 0;
            const float x = bf2f(U[(size_t)(r0 + (ok ? rel : 0)) * 512 + ch]); val[i] = ok ? x : 0.f; }
        __builtin_amdgcn_sched_barrier(0);
#pragma unroll
        for (int o = 0; o < 32; ++o) { float a = cbias;
#pragma unroll
            for (int j = 0; j < 31; ++j) a += w[j] * val[o + j];
            Y[(32 * q + o) * 512 + ch] = a; }
    }
    __syncthreads();
    const f32x4 g0 = *(const f32x4*)(lg + 8 * lane), g1 = *(const f32x4*)(lg + 8 * lane + 4), b0 = *(const f32x4*)(lb + 8 * lane), b1 = *(const f32x4*)(lb + 8 * lane + 4);
    for (int tt = 0; tt < 8; ++tt) {
        const int tok = wave * 8 + tt; const LAS float* yr = Y + tok * 512 + 8 * lane;
        f32x4 a = *(const LAS f32x4*)yr, c = *(const LAS f32x4*)(yr + 4);
        const float mu = wave_sum((a[0] + a[1]) + (a[2] + a[3]) + (c[0] + c[1]) + (c[2] + c[3])) * (1.f / 512.f);
        a = a - mu; c = c - mu;
        const float var = wave_sum((a[0] * a[0] + a[1] * a[1]) + (a[2] * a[2] + a[3] * a[3]) + (c[0] * c[0] + c[1] * c[1]) + (c[2] * c[2] + c[3] * c[3])) * (1.f / 512.f);
        const float rstd = rsqrtf(var + LN_EPS);
        a = a * rstd * g0 + b0; c = c * rstd * g1 + b1;
#pragma unroll
        for (int j = 0; j < 4; ++j) { a[j] = a[j] * sigmoidf_(a[j]); c[j] = c[j] * sigmoidf_(c[j]); }
        const float sm = (float)(1 << SH_MIX);
        u32x2 o; o.x = pk4_fp8(a[0] * sm, a[1] * sm, a[2] * sm, a[3] * sm); o.y = pk4_fp8(c[0] * sm, c[1] * sm, c[2] * sm, c[3] * sm);
        *(u32x2*)((unsigned char*)mix + (size_t)(r0 + tok) * D + 512 + 8 * lane) = o;
    }
    __syncthreads();
}

constexpr int RT_RS = 1032;
constexpr int RT_XL = 32 * RT_RS * 2, RT_PART = 0, RT_LOG = 8 * 32 * 32 * 4, RT_SMALL = AUX_OFF + 4096;
__device__ __forceinline__ void p_router(Frame& F, int layer) {
    PHASE_PROLOGUE();
    const bf16* ypre = WSP(bf16, WS_YPRE); unsigned char* x1f8 = WSP(unsigned char, WS_X1F8);
    const float* g = P->in[layer ? 20 : 8]; const float* bb = P->in[layer ? 21 : 9]; const float* rb = P->in[layer ? 23 : 11];
    const bf16* rwh = WSP(bf16, WS_RWT) + (size_t)(layer * 2) * 4096 * 8; const bf16* rwl = rwh + 4096 * 8;
    unsigned* cnt = ctl + CW_CNT + layer * 2048; int* rowtok = WSP(int, WS_ROWTOK); float* rowgate = WSP(float, WS_ROWGATE);
    LAS bf16* XH = (LAS bf16*)(F.lds); LAS bf16* XL = (LAS bf16*)(F.lds + RT_XL);
    LAS float* PART = (LAS float*)(F.lds + RT_PART); LAS float* LOG = (LAS float*)(F.lds + RT_LOG);
    LAS int* lcnt = (LAS int*)(F.lds + RT_SMALL);
    LAS int* lbase = lcnt + 32;
    LAS int* sel_e = lcnt + 64;
    LAS int* sel_r = sel_e + 256;
    LAS float* sel_g = (LAS float*)(sel_r + 256);
    LAS float* topv = sel_g + 256;
    LAS int* topi = (LAS int*)(topv + 128);
    const int e_l = lane & 31, hi = lane >> 5;
    f32x4 gv[4], bv[4];
#pragma unroll
    for (int j = 0; j < 4; ++j) { gv[j] = *(const f32x4*)(g + 256 * j + 4 * lane); bv[j] = *(const f32x4*)(bb + 256 * j + 4 * lane); }
    const float rbc = rb[tid & 31];
    for (int chunk = (F.xok ? 32 * (F.bid & 7) + (F.bid >> 3) : F.bid); chunk < M / 64; chunk += F.G) {
        if (F.xok) pg8::flow_wait_wg(ctl + CW_RDY + 2048 + 64 * layer + (chunk >> 2), 4, wave);
        if (tid < 32) lcnt[tid] = 0;
        u32x2 yw[2][4][4];
#pragma unroll
        for (int rr = 0; rr < 4; ++rr)
#pragma unroll
            for (int j = 0; j < 4; ++j) { yw[0][rr][j] = *(const u32x2*)(ypre + ((size_t)chunk * 64 + wave * 4 + rr) * D + 256 * j + 4 * lane);
                yw[1][rr][j] = *(const u32x2*)(ypre + ((size_t)chunk * 64 + 32 + wave * 4 + rr) * D + 256 * j + 4 * lane); }
#pragma unroll
        for (int grp = 0; grp < 2; ++grp) {
            __syncthreads();
            bf16x8 bhf[8], blf[8];
#pragma unroll
            for (int ks = 0; ks < 8; ++ks) { const int s = wave * 8 + ks; bhf[ks] = *(const bf16x8*)(rwh + ((size_t)s * 64 + lane) * 8); blf[ks] = *(const bf16x8*)(rwl + ((size_t)s * 64 + lane) * 8); }
#pragma unroll
            for (int rr = 0; rr < 4; ++rr) {
                const int rl = wave * 4 + rr; const size_t row = (size_t)chunk * 64 + grp * 32 + rl;
                f32x4 v[4]; float s = 0.f;
#pragma unroll
                for (int j = 0; j < 4; ++j) { const u32x2 w = yw[grp][rr][j];
                    v[j] = (f32x4){__uint_as_float(w.x << 16), __uint_as_float(w.x & 0xffff0000u), __uint_as_float(w.y << 16), __uint_as_float(w.y & 0xffff0000u)}; s += (v[j][0] + v[j][1]) + (v[j][2] + v[j][3]); }
                const float mu = wave_sum(s) * (1.f / D); float q = 0.f;
#pragma unroll
                for (int j = 0; j < 4; ++j) { v[j] = v[j] - mu; q += (v[j][0] * v[j][0] + v[j][1] * v[j][1]) + (v[j][2] * v[j][2] + v[j][3] * v[j][3]); }
                const float rstd = rsqrtf(wave_sum(q) * (1.f / D) + LN_EPS);
#pragma unroll
                for (int j = 0; j < 4; ++j) { v[j] = v[j] * rstd * gv[j] + bv[j];
                    *(unsigned*)(x1f8 + row * D + 256 * j + 4 * lane) = pk4_fp8(v[j][0], v[j][1], v[j][2], v[j][3]);
                    u32x2 wh, wl; wh.x = cvt_pk_bf16(v[j][0], v[j][1]); wh.y = cvt_pk_bf16(v[j][2], v[j][3]);
                    wl.x = cvt_pk_bf16(v[j][0] - __uint_as_float(wh.x << 16), v[j][1] - __uint_as_float(wh.x & 0xffff0000u)); wl.y = cvt_pk_bf16(v[j][2] - __uint_as_float(wh.y << 16), v[j][3] - __uint_as_float(wh.y & 0xffff0000u));
                    *(LAS u32x2*)(XH + rl * RT_RS + 256 * j + 4 * lane) = wh; *(LAS u32x2*)(XL + rl * RT_RS + 256 * j + 4 * lane) = wl; }
            }
            __syncthreads();
            f32x16 acc = {};
#pragma unroll
            for (int ks = 0; ks < 8; ++ks) { const int s = wave * 8 + ks;
                const bf16x8 ah = *(const LAS bf16x8*)(XH + e_l * RT_RS + 16 * s + 8 * hi), al = *(const LAS bf16x8*)(XL + e_l * RT_RS + 16 * s + 8 * hi);
                const bf16x8 bh = bhf[ks], bl = blf[ks];
                acc = __builtin_amdgcn_mfma_f32_32x32x16_bf16(ah, bh, acc, 0, 0, 0); acc = __builtin_amdgcn_mfma_f32_32x32x16_bf16(al, bh, acc, 0, 0, 0); acc = __builtin_amdgcn_mfma_f32_32x32x16_bf16(ah, bl, acc, 0, 0, 0); }
            __syncthreads();
#pragma unroll
            for (int gq = 0; gq < 16; ++gq) PART[(wave * 32 + crow(gq, hi)) * 32 + e_l] = acc[gq];
            __syncthreads();
#pragma unroll
            for (int k = 0; k < 2; ++k) { const int idx = tid + 512 * k; float sm = 0.f;
#pragma unroll
                for (int w = 0; w < 8; ++w) sm += PART[w * 1024 + idx];
                LOG[idx] = sm + rbc; }
            __syncthreads();
            int l2 = lane; asm volatile("" : "+v"(l2)); const int e_l = l2 & 31, hi = l2 >> 5;
            for (int pr = 0; pr < 2; ++pr) {
                const int rl = wave * 4 + pr * 2 + hi; const LAS float* lrow = LOG + rl * 32;
                const float mine = lrow[e_l]; int rank = 0;
#pragma unroll
                for (int i = 0; i < 8; ++i) { const f32x4 o = *(const LAS f32x4*)(lrow + 4 * i);
#pragma unroll
                    for (int c = 0; c < 4; ++c) rank += (o[c] > mine || (o[c] == mine && 4 * i + c < e_l)) ? 1 : 0; }
                if (rank < 4) { topv[rl * 4 + rank] = mine; topi[rl * 4 + rank] = e_l; }
                if (e_l < 4) {
                    const f32x4 sv = *(const LAS f32x4*)(topv + rl * 4);
                    const float e1 = __expf(sv[1] - sv[0]), e2 = __expf(sv[2] - sv[0]), e3 = __expf(sv[3] - sv[0]);
                    const float inv = 1.f / (((1.f + e1) + e2) + e3);
                    const int ek = topi[rl * 4 + e_l];
                    const float gk = (e_l == 0 ? 1.f : e_l == 1 ? e1 : e_l == 2 ? e2 : e3) * inv;
                    const int lr = __hip_atomic_fetch_add(lcnt + ek, 1, __ATOMIC_RELAXED, __HIP_MEMORY_SCOPE_WORKGROUP);
                    const int idx = (grp * 32 + rl) * 4 + e_l; sel_e[idx] = ek; sel_g[idx] = gk; sel_r[idx] = lr;
                }
            }
        }
        __syncthreads();
        { int t2 = tid; asm volatile("" : "+v"(t2));
          if (t2 < 32) lbase[t2] = (int)__hip_atomic_fetch_add(cnt + 64 * t2, (unsigned)lcnt[t2], __ATOMIC_RELAXED, __HIP_MEMORY_SCOPE_AGENT);
          __syncthreads();
          if (t2 < 256) { const int e = sel_e[t2]; const int pos = lbase[e] + sel_r[t2];
              rowtok[e * CAP + pos] = (chunk * 64 + (t2 >> 2)) * 4 + (t2 & 3); rowgate[e * CAP + pos] = sel_g[t2]; } }
        __syncthreads();
    }
}

__device__ __forceinline__ void p_combine(Frame& F, int layer) {
    PHASE_PROLOGUE();
    const bf16* ypre = WSP(bf16, WS_YPRE); const bf16* ys = WSP(bf16, WS_YSLOT);
    const float* g = P->in[layer ? 28 : 16]; const float* bb = P->in[layer ? 29 : 17]; const float* g1 = P->in[layer ? 20 : 8]; const float* b1 = P->in[layer ? 21 : 9];
    float* xo = P->out; bf16* xob = WSP(bf16, WS_X2B);
    const int gw = F.bid * NWAVES + wave, NGW = F.G * NWAVES;
    f32x4 gv[4], bv[4];
#pragma unroll
    for (int j = 0; j < 4; ++j) { gv[j] = *(const f32x4*)(g + 256 * j + 4 * lane); bv[j] = *(const f32x4*)(bb + 256 * j + 4 * lane); }
    f32x4 g1v[4], b1v[4];
#pragma unroll
    for (int j = 0; j < 4; ++j) { g1v[j] = *(const f32x4*)(g1 + 256 * j + 4 * lane); b1v[j] = *(const f32x4*)(b1 + 256 * j + 4 * lane); }
    static_assert(YS8, "the prefetching combine reads fp8 slots");
    u32x2 pyw[4]; int psw[4][4];
#pragma unroll
    for (int j = 0; j < 4; ++j) { pyw[j] = *(const u32x2*)(ypre + (size_t)gw * D + 256 * j + 4 * lane);
#pragma unroll
        for (int k = 0; k < 4; ++k) psw[j][k] = *(const int*)((const unsigned char*)ys + ((size_t)gw * 4 + k) * D + 256 * j + 4 * lane); }
    for (int row = gw; row < M; row += NGW) {
        f32x4 v[4]; float s = 0.f;
        u32x2 cyw[4]; int csw[4][4];
#pragma unroll
        for (int j = 0; j < 4; ++j) { cyw[j] = pyw[j];
#pragma unroll
            for (int k = 0; k < 4; ++k) csw[j][k] = psw[j][k]; }
        if (row + NGW < M) { const size_t nr = (size_t)row + NGW;
#pragma unroll
            for (int j = 0; j < 4; ++j) { pyw[j] = *(const u32x2*)(ypre + nr * D + 256 * j + 4 * lane);
#pragma unroll
                for (int k = 0; k < 4; ++k) psw[j][k] = *(const int*)((const unsigned char*)ys + (nr * 4 + k) * D + 256 * j + 4 * lane); } }
        { float s1 = 0.f;
#pragma unroll
          for (int j = 0; j < 4; ++j) { const u32x2 w = cyw[j];
              v[j] = (f32x4){__uint_as_float(w.x << 16), __uint_as_float(w.x & 0xffff0000u), __uint_as_float(w.y << 16), __uint_as_float(w.y & 0xffff0000u)}; s1 += (v[j][0] + v[j][1]) + (v[j][2] + v[j][3]); }
          const float mu1 = wave_sum(s1) * (1.f / D); float q1 = 0.f;
#pragma unroll
          for (int j = 0; j < 4; ++j) { v[j] = v[j] - mu1; q1 += (v[j][0] * v[j][0] + v[j][1] * v[j][1]) + (v[j][2] * v[j][2] + v[j][3] * v[j][3]); }
          const float rstd1 = rsqrtf(wave_sum(q1) * (1.f / D) + LN_EPS);
#pragma unroll
          for (int j = 0; j < 4; ++j) v[j] = (v[j] * rstd1 * g1v[j] + b1v[j]) * ALPHA; }
#pragma unroll
        for (int j = 0; j < 4; ++j) {
#pragma unroll
            for (int k = 0; k < 4; ++k) {
                if constexpr (YS8) { const int w = csw[j][k]; const float iy = 1.f / (float)(1 << SH_Y);
                    const f32x2 lo = __builtin_amdgcn_cvt_pk_f32_fp8(w, false), hi = __builtin_amdgcn_cvt_pk_f32_fp8(w, true);
                    v[j][0] += lo[0] * iy; v[j][1] += lo[1] * iy; v[j][2] += hi[0] * iy; v[j][3] += hi[1] * iy; }
                else { const u32x2 w = *(const u32x2*)(ys + ((size_t)row * 4 + k) * D + 256 * j + 4 * lane);
                    v[j][0] += __uint_as_float(w.x << 16); v[j][1] += __uint_as_float(w.x & 0xffff0000u); v[j][2] += __uint_as_float(w.y << 16); v[j][3] += __uint_as_float(w.y & 0xffff0000u); } }
            s += (v[j][0] + v[j][1]) + (v[j][2] + v[j][3]); }
        const float mu = wave_sum(s) * (1.f / D); float q = 0.f;
#pragma unroll
        for (int j = 0; j < 4; ++j) { v[j] = v[j] - mu; q += (v[j][0] * v[j][0] + v[j][1] * v[j][1]) + (v[j][2] * v[j][2] + v[j][3] * v[j][3]); }
        const float rstd = rsqrtf(wave_sum(q) * (1.f / D) + LN_EPS);
#pragma unroll
        for (int j = 0; j < 4; ++j) { v[j] = v[j] * rstd * gv[j] + bv[j];
            if (layer) *(f32x4*)(xo + (size_t)row * D + 256 * j + 4 * lane) = v[j];
            else { u32x2 w; w.x = cvt_pk_bf16(v[j][0], v[j][1]); w.y = cvt_pk_bf16(v[j][2], v[j][3]); *(u32x2*)(xob + (size_t)row * D + 256 * j + 4 * lane) = w; } }
    }
}
__device__ __forceinline__ void p_attn(Frame& F) {
    PHASE_PROLOGUE();
    const bf16* Q = WSP(bf16, WS_QK1); const bf16* Kt = Q + (size_t)M * D; const bf16* VT = WSP(bf16, WS_VT1); bf16* AO = WSP(bf16, WS_AO);
    const int r = lane & 31, hh = lane >> 5;
    const int pir = (r & 0x13) | ((r & 4) << 1) | ((r & 8) >> 1);
    for (int wu = F.bid * NWAVES + wave; wu < BATCH * 8 * (SEQ / 32); wu += F.G * NWAVES) {
        const int qb = wu & 127, bhd = wu >> 7, b = bhd >> 3, hd = bhd & 7;
        const size_t tok0 = (size_t)b * SEQ; const int q0 = 32 * qb;
        bf16x8 qf[8];
#pragma unroll
        for (int s = 0; s < 8; ++s) qf[s] = *(const bf16x8*)(Q + (tok0 + q0 + r) * D + hd * 128 + 16 * s + 8 * hh);
        f32x16 o[4];
#pragma unroll
        for (int et = 0; et < 4; ++et) o[et] = (f32x16){};
        float carry = 1.f;
        bf16x8 kf[8];
        { const bf16* kp = Kt + ((size_t)bhd * SEQ + q0) * 128 + lane * 8;
#pragma unroll
          for (int s = 0; s < 8; ++s) kf[s] = *(const bf16x8*)(kp + 512 * s); }
        for (int kb = qb; kb >= 0; --kb) {
            const int k0 = 32 * kb;
            f32x16 st = {};
#pragma unroll
            for (int s = 0; s < 8; ++s) st = __builtin_amdgcn_mfma_f32_32x32x16_bf16(kf[s], qf[s], st, 0, 0, 0);
            if (kb > 0) { const bf16* kp = Kt + ((size_t)bhd * SEQ + k0 - 32) * 128 + lane * 8;
#pragma unroll
                for (int s = 0; s < 8; ++s) kf[s] = *(const bf16x8*)(kp + 512 * s); }
            float bt[16], omb[16];
#pragma unroll
            for (int g = 0; g < 16; ++g) { const float z = __builtin_amdgcn_fmed3f(st[g], -80.f, 80.f); const float ez = __builtin_amdgcn_exp2f(-z); bt[g] = __builtin_amdgcn_rcpf(1.f + ez); omb[g] = ez * bt[g]; }
            if (kb == qb) {
#pragma unroll
                for (int g = 0; g < 16; ++g) { const int kl = 16 * (g >> 3) + 8 * hh + (g & 7); if (kl >= r) { bt[g] = 0.f; omb[g] = 1.f; } } }
            float rA = omb[0], rB = omb[8];
#pragma unroll
            for (int g = 1; g < 8; ++g) { rA *= omb[g]; rB *= omb[g + 8]; }
            float pA, pB;
            { const unsigned ua = __float_as_uint(rA), ub = __float_as_uint(rB);
              const auto sa = __builtin_amdgcn_permlane32_swap(ua, ua, false, false); const auto sb = __builtin_amdgcn_permlane32_swap(ub, ub, false, false);
              pA = __uint_as_float(hh ? sa[0] : sa[1]); pB = __uint_as_float(hh ? sb[0] : sb[1]); }
            float a[16];
            float run = carry * (hh ? 1.f : pB);
#pragma unroll
            for (int g = 15; g >= 8; --g) { a[g] = bt[g] * run; run *= omb[g]; }
            run = carry * (rB * pB) * (hh ? 1.f : pA);
#pragma unroll
            for (int g = 7; g >= 0; --g) { a[g] = bt[g] * run; run *= omb[g]; }
            carry *= (rA * rB) * (pA * pB);
#pragma unroll
            for (int s = 0; s < 2; ++s) {
                u32x4 pw; pw.x = cvt_pk_bf16(a[8 * s + 0], a[8 * s + 1]); pw.y = cvt_pk_bf16(a[8 * s + 2], a[8 * s + 3]); pw.z = cvt_pk_bf16(a[8 * s + 4], a[8 * s + 5]); pw.w = cvt_pk_bf16(a[8 * s + 6], a[8 * s + 7]);
#pragma unroll
                for (int et = 0; et < 4; ++et) { const bf16x8 vf = *(const bf16x8*)(VT + ((size_t)bhd * SEQ + k0) * 128 + ((s * 4 + et) * 64 + lane) * 8);
                    o[et] = __builtin_amdgcn_mfma_f32_32x32x16_bf16(__builtin_bit_cast(bf16x8, pw), vf, o[et], 0, 0, 0); }
            }
            if (__all(carry < SB_EXIT)) break;
        }
#pragma unroll
        for (int et = 0; et < 4; ++et)
#pragma unroll
            for (int g = 0; g < 16; ++g) ((unsigned char*)AO)[(tok0 + q0 + crow(g, hh)) * D + hd * 128 + 32 * et + r] = fp8_1(o[et][g] * (float)(1 << SH_MIX));
    }
}

#ifndef MOE_ALIGN_EPI
#define MOE_ALIGN_EPI 1
#endif
constexpr bool MOE_ALIGN = MOE_ALIGN_EPI != 0;
constexpr int AUX_T2E = AUX_OFF, AUX_TSTART = AUX_OFF + 1280, AUX_TAB = AUX_OFF + 1536, AUX_BIAS = AUX_OFF + 1536 + 10240;
static_assert(AUX_BIAS + 3072 <= AUX_OFF + AUX_BYTES, "AUX map");
__device__ __forceinline__ int build_tiles(Frame& F, const unsigned* cnt) {
    PHASE_PROLOGUE();
    LAS int* t2e = (LAS int*)(F.lds + AUX_T2E); LAS int* ts = (LAS int*)(F.lds + AUX_TSTART);
    if (tid < NE) t2e[288 + tid] = (int)cnt[64 * tid];
    __syncthreads();
    if (tid == 0) { int T = 0;
        for (int e = 0; e < NE; ++e) { ts[e] = T; const int n = (t2e[288 + e] + 255) >> 8; for (int i = 0; i < n; ++i) t2e[T + i] = e; T += n; }
        ts[NE] = T; }
    __syncthreads();
    return ts[NE];
}

#ifdef ONLY_PHASE
#define IN(k) ((k) == ONLY_PHASE)
#else
#define IN(k) (lo <= (k) && (k) < hi)
#endif
#define SEAM(k) do { if (IN(k) && IN((k) + 1)) xcd_barrier(bar); } while (0)
template <int layer>
__device__ __forceinline__ void layer_phases(Frame& F, const XcdBarrier& bar, const int lo, const int hi) {
    LAS unsigned char* ring = F.lds + RING_OFF;
    {
        constexpr int pb = layer ? 12 : 5;
        if constexpr (layer == 1) {
            if (IN(10)) { PHASE_PROLOGUE();
                { pg8::Gemm g{WSP(bf16, WS_X2B), WSP(bf16, WS_WIN1), M, 2 * D, D, 0, 0};
                  pg8::StaticOrder S; S.init(M / 256, 2 * D / 256, F.G, F.bid, nullptr);
                  pg8::EpiQK E{WSP(bf16, WS_QK1), WSP(bf16, WS_QK1) + (size_t)M * D, QSCALE1};
                  pg8::gemm_phase<pg8::EpiQK, false, true>(ring, g, S, E, nullptr, F.wave); }
                { pg8::Gemm g{WSP(bf16, WS_WIN1) + (size_t)2 * D * D, WSP(bf16, WS_X2B), D, M, D, 0, 0};
                  pg8::StaticOrder S; S.init(D / 256, M / 256, F.G, F.bid, nullptr);
                  pg8::EpiVT E{WSP(bf16, WS_VT1)};
                  pg8::gemm_phase<pg8::EpiVT, false, true>(ring, g, S, E, nullptr, F.wave); }
            } SEAM(10);
            if (IN(11)) { p_attn(F);
            } SEAM(11);
        }
        if (IN(pb)) { PHASE_PROLOGUE();
            pg8::Gemm g{layer ? WSP(bf16, WS_AO) : WSP(bf16, WS_MIX), WSP(bf16, layer ? WS_WOUT1 : WS_WOUT0), M, D, D, 0, SCL_OUT, ctl + CW_RDY + 2048 + 64 * layer};
            pg8::StaticOrder S; S.init(M / 256, D / 256, F.G, F.bid, nullptr);
            pg8::EpiResid<true> E{layer ? (const void*)WSP(bf16, WS_X2B) : (const void*)WSP(bf16, WS_XBF), WSP(bf16, WS_YPRE)};
            pg8::gemm_phase<pg8::EpiResid<true>, false, true, true, pg8::NoRide, pg8::StaticOrder, 1>(ring, g, S, E, nullptr, F.wave);
        }
        if (IN(pb) && IN(pb + 1) && !F.xok) xcd_barrier(bar);
        if (IN(pb + 1)) { p_router(F, layer); } SEAM(pb + 1);
        if (IN(pb + 2)) { PHASE_PROLOGUE(); const unsigned* cnt = ctl + CW_CNT + layer * 2048;
            const int T = build_tiles(F, cnt);
            const LAS int* t2e = (const LAS int*)(F.lds + AUX_T2E); const LAS int* ts = (const LAS int*)(F.lds + AUX_TSTART);
            LAS int* rowtab = (LAS int*)(F.lds + AUX_TAB);
            pg8::XcdOrder S; S.init(T, 2 * FF / 256, F.G, F.bid, 0, t2e);
            const int* rowtok = WSP(int, WS_ROWTOK);
            { const int nu = S.count();
#pragma unroll 5
              for (int en = tid; en < nu * 256; en += 512) { pg8::Unit u; S.next(en >> 8, u); const int idx = (u.pm - ts[u.e]) * 256 + (en & 255); const bool ok = idx < t2e[288 + u.e];
                  rowtab[en] = rowtok[u.e * CAP + (ok ? idx : 0)] >> 2; } }
            __syncthreads();
            constexpr bool F8 = MOE_FP8[layer];
            pg8::Gemm g{F8 ? WSP(void, WS_X1F8) : WSP(void, WS_X1B), WSP(bf16, layer ? WS_WUP1 : WS_WUP0), T * 256, 2 * FF, D, (size_t)2 * FF * D * (F8 ? 1 : 2), SCL_UP, ctl + CW_RDY + 512 * layer};
            pg8::EpiUp<F8> E{P->in[layer ? 25 : 13], WSP(void, WS_ACT), (LAS float*)(F.lds + AUX_BIAS)};
            if constexpr (layer == 0) { MoeRide R; R.P = P; R.ws = ws; R.base = MOE_ITEMS_L; R.limit = MOE_ITEMS; R.ok = false;
                pg8::gemm_phase<pg8::EpiUp<F8>, true, MOE_ALIGN, F8, MoeRide, pg8::XcdOrder, 1>(ring, g, S, E, rowtab, F.wave, R); }
            else pg8::gemm_phase<pg8::EpiUp<F8>, true, MOE_ALIGN, F8, pg8::NoRide, pg8::XcdOrder, 1>(ring, g, S, E, rowtab, F.wave);
        }
        if (IN(pb + 2) && IN(pb + 3) && !F.xok) { if constexpr (layer == 1) xcd_barrier<false>(bar); else xcd_barrier(bar); }
        if (IN(pb + 3)) { PHASE_PROLOGUE(); const unsigned* cnt = ctl + CW_CNT + layer * 2048;
            int T; if (IN(pb + 2)) { __syncthreads(); T = ((const LAS int*)(F.lds + AUX_TSTART))[NE]; } else T = build_tiles(F, cnt);
            const LAS int* t2e = (const LAS int*)(F.lds + AUX_T2E); const LAS int* ts = (const LAS int*)(F.lds + AUX_TSTART);
            LAS int* ttok = (LAS int*)(F.lds + AUX_TAB); LAS float* tgate = (LAS float*)(F.lds + AUX_TAB + 5 * 1024);
            pg8::XcdOrder S; S.init(T, D / 256, F.G, F.bid, 2 * FF / 256, t2e);
            const int* rowtok = WSP(int, WS_ROWTOK); const float* rowgate = WSP(float, WS_ROWGATE);
            { const int nu = S.count();
#pragma unroll 3
              for (int en = tid; en < nu * 256; en += 512) { pg8::Unit u; S.next(en >> 8, u); const int idx = (u.pm - ts[u.e]) * 256 + (en & 255); const bool ok = idx < t2e[288 + u.e];
                  ttok[en] = ok ? rowtok[u.e * CAP + idx] : -1; tgate[en] = ok ? rowgate[u.e * CAP + idx] : 0.f; } }
            __syncthreads();
            constexpr bool F8 = MOE_FP8[layer];
            pg8::Gemm g{WSP(bf16, WS_ACT), WSP(bf16, layer ? WS_WDN1 : WS_WDN0), T * 256, D, FF, (size_t)D * FF * (F8 ? 1 : 2), SCL_DN, ctl + CW_RDY + 512 * layer};
            pg8::EpiDown E{P->in[layer ? 27 : 15], WSP(bf16, WS_YSLOT), ttok, tgate, (LAS float*)(F.lds + AUX_BIAS)};
            if constexpr (layer == 0) { MoeRide R; R.P = P; R.ws = ws; R.base = MOE_ITEMS_L + T * 64; R.limit = MOE_ITEMS; R.ok = false;
                pg8::gemm_phase<pg8::EpiDown, false, MOE_ALIGN, F8, MoeRide, pg8::XcdOrder, 2, 2 * FF / 256>(ring, g, S, E, nullptr, F.wave, R); }
            else pg8::gemm_phase<pg8::EpiDown, false, MOE_ALIGN, F8, pg8::NoRide, pg8::XcdOrder, 2, 2 * FF / 256>(ring, g, S, E, nullptr, F.wave);
        }
        if (IN(pb + 3) && IN(pb + 4)) { if constexpr (layer == 1) xcd_barrier<false>(bar); else xcd_barrier(bar); }
        if (IN(pb + 4)) { p_combine(F, layer); }
        if constexpr (layer == 0) SEAM(pb + 4);
    }
}
#undef IN
#undef SEAM
__global__ void __launch_bounds__(NWAVES * 64, 2) mega(Params Pk) {
    extern __shared__ __attribute__((aligned(16))) unsigned char lds_raw[];
    Frame F; F.lds = (LAS unsigned char*)lds_raw; F.G = gridDim.x; F.bid = blockIdx.x; F.wave = __builtin_amdgcn_readfirstlane(threadIdx.x >> 6); F.xok = 0;
    volatile LAS unsigned* MISC = (volatile LAS unsigned*)(F.lds + LCTL_OFF);
    if (threadIdx.x < 256) MISC[threadIdx.x] = 0u;
    __syncthreads();
    XcdBarrier bar = xcd_barrier_post((unsigned*)(Pk.ws + WS_CTL) + CW_BAR + Pk.li * XCD_BAR_WORDS, MISC + 8);
    const int lo = Pk.ph_lo, hi = Pk.ph_hi;
#ifdef ONLY_PHASE
#define IN(k) ((k) == ONLY_PHASE)
#else
#define IN(k) (lo <= (k) && (k) < hi)
#endif
#define SEAM(k) do { if (IN(k) && IN((k) + 1)) xcd_barrier(bar); } while (0)
    LAS unsigned char* ring = F.lds + RING_OFF;

    if (IN(0)) { p0_prep(F); } SEAM(0);
    if (IN(0) && IN(1)) { const unsigned* barw = (const unsigned*)(Pk.ws + WS_CTL) + CW_BAR + Pk.li * XCD_BAR_WORDS; bool even = true;
        for (int j = 0; j < 16; ++j) { const unsigned c = __builtin_nontemporal_load(barw + XB_XCNT(j)); even = even && (c == (j < 8 ? (unsigned)F.G / 8u : 0u)); }
        if (even && (F.G & 7) == 0) { F.bid = (int)(MISC[10] * 8u + MISC[11]); F.xok = 1; } }

    if (IN(1)) { PHASE_PROLOGUE();
        pg8::Gemm g{WSP(bf16, WS_XBF), WSP(bf16, WS_WIN0), M, L0N, D, 0, 0};
        pg8::StaticOrder S; S.init(M / 256, L0N / 256, F.G, F.bid, nullptr);
        pg8::EpiInProj0 E{WSP(bf16, WS_Q0), WSP(bf16, WS_K0), WSP(bf16, WS_V0), WSP(bf16, WS_SG), WSP(bf16, WS_U), WSP(float, WS_ROPE)};
        pg8::gemm_phase<pg8::EpiInProj0, false, true>(ring, g, S, E, nullptr, F.wave);
        if (F.bid >= 128) moe_convert(F, CONV_A0 + CONV_P2 + (F.bid - 128) * CONV_C1 + F.wave, CONV_C1 / 8, 8, MOE_ITEMS_L);
    } SEAM(1);

    if (IN(2)) { for (int u = F.bid; u < 256 + 1024; u += F.G) { if (u < 256) p2_conv_unit(F, u); else p2_kv_unit(F, u - 256, CONV_A0 + (u - 256) * 8 + F.wave); } } SEAM(2);
    if (IN(3)) { p2_scan(F); } SEAM(3);
    if (IN(4)) { for (int wu = F.bid * NWAVES + F.wave; wu < 2048; wu += F.G * NWAVES) p2_ret_wave(F, wu); } SEAM(4);

    layer_phases<0>(F, bar, lo, hi);
    layer_phases<1>(F, bar, lo, hi);
#undef IN
#undef SEAM
}
static void launch_mega(const Params& base, int lo, int hi, int li, int grid, hipStream_t stream) {
    Params p = base; p.ph_lo = lo; p.ph_hi = hi; p.li = li; p.pad = 0;
    hipLaunchKernelGGL(mega, dim3(grid), dim3(NWAVES * 64), LDS_BYTES, stream, p);
}
extern "C" void kernel_launch(void* const* d_in, const int* in_sizes, int n_in, void* d_out, int out_size, void* d_ws, size_t ws_size, hipStream_t stream) {
    static int grid = 0;
    if (grid == 0) {
        if (n_in != 30 || ws_size < WS_END || out_size != M * D) { fprintf(stderr, "kernel_launch: unexpected shapes n_in=%d ws=%zu out=%d\n", n_in, ws_size, out_size); grid = -1; return; }
        int dev = 0, cus = 0, per_cu = 0;
        if (hipGetDevice(&dev) != hipSuccess || hipDeviceGetAttribute(&cus, hipDeviceAttributeMultiprocessorCount, dev) != hipSuccess) { grid = -1; return; }
        if (hipFuncSetAttribute((const void*)mega, hipFuncAttributeMaxDynamicSharedMemorySize, LDS_BYTES) != hipSuccess) { fprintf(stderr, "kernel_launch: hipFuncSetAttribute failed\n"); grid = -1; return; }
        if (hipOccupancyMaxActiveBlocksPerMultiprocessor(&per_cu, (const void*)mega, NWAVES * 64, LDS_BYTES) != hipSuccess || per_cu < 1) { fprintf(stderr, "kernel_launch: occupancy query says %d\n", per_cu); (void)hipGetLastError(); grid = -1; return; }
        grid = cus;
        if (grid != 256) { fprintf(stderr, "kernel_launch: built for 256 CUs, device has %d\n", cus); grid = -1; return; }
    }
    if (grid < 0) return;
    (void)hipMemsetAsync((char*)d_ws + WS_CTL, 0, 1 * MiB, stream);
    Params a{};
    for (int i = 0; i < 30; ++i) a.in[i] = (const float*)d_in[i];
    a.out = (float*)d_out; a.ws = (unsigned char*)d_ws;
    launch_mega(a, 0, 17, 0, grid, stream);
}
```
